# Optimizing an MI355X kernel written in HIP

```python
import jax, jax.numpy as jnp
from jax import lax
import numpy as np

D_MODEL = 1024
BATCH = 2
SEQ = 8192
DEPTH = 1

GRID_W = 64
CTX_LEN = 256
RET_HEADS = 8
RET_QK_DIM = 64
RET_V_DIM = 128
RET_QK_WIDTH = RET_HEADS * RET_QK_DIM
RET_V_WIDTH = RET_HEADS * RET_V_DIM
CHUNK = 128
ROPE_BASE = 10000.0
FOURIER_GROUPS = 4
FOURIER_GROUP_DIM = 128
FOURIER_WIDTH = FOURIER_GROUPS * FOURIER_GROUP_DIM
Q_OFF = 0
K_OFF = Q_OFF + RET_QK_WIDTH
V_OFF = K_OFF + RET_QK_WIDTH
G_OFF = V_OFF + RET_V_WIDTH
F_OFF = G_OFF + RET_V_WIDTH
IN_COLS = F_OFF + FOURIER_WIDTH
N_BRANCHES = 2
FFN_DIM = 2816
CONV_W = 3
N_MOD = 6
EPS = 1e-6

kernel_name = "hybrid_retention_fourier_convffn_dit_block"


def rms_norm(x, w):
    x32 = x.astype(jnp.float32)
    y = x32 * lax.rsqrt(jnp.mean(x32 * x32, axis=-1, keepdims=True) + EPS)
    return (y * w.astype(jnp.float32)).astype(x.dtype)


def modulate(h, shift, scale):
    return h * (1 + scale) + shift


def split_heads(t, n_heads):
    b, l, w = t.shape
    return t.reshape(b, l, n_heads, w // n_heads).transpose(0, 2, 1, 3)


def rope_2d(t, row, col):
    n_freq = RET_QK_DIM // 4
    inv = ROPE_BASE ** (-jnp.arange(n_freq, dtype=jnp.float32) / n_freq)
    ang = jnp.concatenate([row[:, None] * inv, col[:, None] * inv], axis=-1)
    cos, sin = jnp.cos(ang), jnp.sin(ang)
    half = RET_QK_DIM // 2
    t1, t2 = t[..., :half], t[..., half:]
    return jnp.concatenate([t1 * cos - t2 * sin, t1 * sin + t2 * cos], axis=-1).astype(t.dtype)


def log_gamma(a):
    return -jnp.exp(a.astype(jnp.float32))


def chunk_retention(q, k, v, a, s0):
    b, h, l, dk = q.shape
    dv = v.shape[-1]
    n = l // CHUNK
    lg = log_gamma(a)
    qc = q.reshape(b, h, n, CHUNK, dk)
    kc = k.reshape(b, h, n, CHUNK, dk)
    vc = v.reshape(b, h, n, CHUNK, dv)
    pos = jnp.arange(CHUNK, dtype=jnp.float32)
    diff = pos[:, None] - pos[None, :]
    intra_decay = jnp.where(diff >= 0, jnp.exp(lg[:, None, None] * jnp.maximum(diff, 0.0)), 0.0)
    scores = jnp.einsum('bhncd,bhnsd->bhncs', qc, kc) * intra_decay[None, :, None]
    intra = jnp.einsum('bhncs,bhnse->bhnce', scores, vc)
    k_dec = kc * jnp.exp(lg[:, None] * (CHUNK - 1 - pos))[None, :, None, :, None]
    kv = jnp.einsum('bhnsd,bhnse->nbhde', k_dec, vc)
    chunk_decay = jnp.exp(lg * CHUNK)[None, :, None, None]

    def step(s, kv_n):
        return chunk_decay * s + kv_n, s

    s_final, s_prev = lax.scan(step, s0.astype(jnp.float32), kv)
    q_dec = qc * jnp.exp(lg[:, None] * (pos + 1))[None, :, None, :, None]
    inter = jnp.einsum('bhncd,nbhde->bhnce', q_dec, s_prev)
    return (intra + inter).reshape(b, h, l, dv), s_final


def retention_state(k, v, a):
    l = k.shape[2]
    lg = log_gamma(a)
    w = jnp.exp(lg[:, None] * (l - 1 - jnp.arange(l, dtype=jnp.float32)))
    return jnp.einsum('bhld,bhle,hl->bhde', k, v, w)


def bidir_retention(q, k, v, a_f, a_b, s_f0, s_b0):
    o_f, s_f = chunk_retention(q, k, v, a_f, s_f0)
    o_b, s_b = chunk_retention(jnp.flip(q, 2), jnp.flip(k, 2), jnp.flip(v, 2), a_b, s_b0)
    return o_f + jnp.flip(o_b, 2), s_f, s_b


def ret_readout(o, g, w_o):
    mu = jnp.mean(o, axis=-1, keepdims=True)
    var = jnp.mean(jnp.square(o - mu), axis=-1, keepdims=True)
    o = (o - mu) * lax.rsqrt(var + EPS)
    b, h, l, dv = o.shape
    o = o.transpose(0, 2, 1, 3).reshape(b, l, h * dv).astype(g.dtype)
    return (o * jax.nn.silu(g)) @ w_o


def fourier_mix(f, w_f):
    b, l, _ = f.shape
    fg = f.reshape(b, l, FOURIER_GROUPS, FOURIER_GROUP_DIM).astype(jnp.float32)
    z = jnp.fft.fft2(fg, axes=(1, 3), norm='ortho').real
    return z.reshape(b, l, FOURIER_WIDTH).astype(f.dtype) @ w_f


def merge_branches(h, ret_d, four_d, w_bg, b_bg, w_out):
    gates = jax.nn.sigmoid(h @ w_bg + b_bg)
    g_r, g_f = jnp.split(gates, N_BRANCHES, axis=-1)
    return (g_r * ret_d + g_f * four_d) @ w_out


def depthwise_conv3(u, w, b):
    up = jnp.pad(u, ((0, 0), (1, 1), (0, 0)))
    return up[:, :-2] * w[0] + up[:, 1:-1] * w[1] + up[:, 2:] * w[2] + b


def conv_ffn(h, w_up, conv_w, conv_b, w_down):
    u = depthwise_conv3(h @ w_up, conv_w, conv_b)
    a, val = jnp.split(u, 2, axis=-1)
    return (jax.nn.gelu(a) * val) @ w_down


def split_proj(p):
    return (p[..., Q_OFF:K_OFF], p[..., K_OFF:V_OFF], p[..., V_OFF:G_OFF],
            p[..., G_OFF:F_OFF], p[..., F_OFF:IN_COLS])


def setup_inputs(seed: int = 0) -> dict:
    key = jax.random.key(seed)
    ks = jax.random.split(key, 24)

    def nrm(k, shape, scale):
        return jax.random.normal(k, shape, jnp.float32) * scale

    d = D_MODEL
    base_decay = jnp.log(-jnp.log1p(-(2.0 ** (-5.0 - jnp.arange(RET_HEADS, dtype=jnp.float32)))))
    return {
        "x": nrm(ks[0], (BATCH, SEQ, d), 1.0),
        "c": nrm(ks[1], (BATCH, d), 1.0),
        "ctx": nrm(ks[2], (BATCH, CTX_LEN, d), 1.0),
        "c_ctx": nrm(ks[3], (d,), 1.0),
        "w_mod": nrm(ks[4], (DEPTH, d, N_MOD * d), 0.5 * d ** -0.5),
        "b_mod": nrm(ks[5], (DEPTH, N_MOD * d), 0.01),
        "norm1_w": 1.0 + nrm(ks[6], (DEPTH, d), 0.05),
        "w_in": nrm(ks[7], (DEPTH, d, IN_COLS), d ** -0.5),
        "ret_decay_f": base_decay[None] + nrm(ks[8], (DEPTH, RET_HEADS), 0.1),
        "ret_decay_b": base_decay[None] + nrm(ks[9], (DEPTH, RET_HEADS), 0.1),
        "w_ret_out": nrm(ks[10], (DEPTH, RET_V_WIDTH, d), RET_V_WIDTH ** -0.5),
        "w_four_out": nrm(ks[11], (DEPTH, FOURIER_WIDTH, d), FOURIER_WIDTH ** -0.5),
        "w_branch_gate": nrm(ks[12], (DEPTH, d, N_BRANCHES * d), d ** -0.5),
        "b_branch_gate": nrm(ks[13], (DEPTH, N_BRANCHES * d), 0.01),
        "w_out": nrm(ks[14], (DEPTH, d, d), d ** -0.5),
        "norm2_w": 1.0 + nrm(ks[15], (DEPTH, d), 0.05),
        "w_up": nrm(ks[16], (DEPTH, d, 2 * FFN_DIM), d ** -0.5),
        "conv_w": nrm(ks[17], (DEPTH, CONV_W, 2 * FFN_DIM), CONV_W ** -0.5),
        "conv_b": nrm(ks[18], (DEPTH, 2 * FFN_DIM), 0.01),
        "w_down": nrm(ks[19], (DEPTH, FFN_DIM, d), FFN_DIM ** -0.5),
        "final_norm_w": 1.0 + nrm(ks[20], (d,), 0.05),
    }


def reference(x, c, ctx, c_ctx, w_mod, b_mod, norm1_w, w_in, ret_decay_f, ret_decay_b,
              w_ret_out, w_four_out, w_branch_gate, b_branch_gate, w_out, norm2_w,
              w_up, conv_w, conv_b, w_down, final_norm_w):
    b, l, _ = x.shape
    rows = l // GRID_W
    row = jnp.repeat(jnp.arange(rows, dtype=jnp.float32), GRID_W)
    col = jnp.tile(jnp.arange(GRID_W, dtype=jnp.float32), rows)
    q_scale = RET_QK_DIM ** -0.5
    silu_c = jax.nn.silu(c)
    silu_cc = jax.nn.silu(c_ctx)
    xc = ctx
    for layer in range(DEPTH):
        last = layer == DEPTH - 1
        wi = w_in[layer]
        a_f, a_b = ret_decay_f[layer], ret_decay_b[layer]
        mod = silu_c @ w_mod[layer] + b_mod[layer]
        sh1, sc1, g1, sh2, sc2, g2 = [m[:, None, :] for m in jnp.split(mod, N_MOD, axis=-1)]
        mc = jnp.split(silu_cc @ w_mod[layer] + b_mod[layer], N_MOD)

        h = modulate(rms_norm(x, norm1_w[layer]), sh1, sc1)
        hc = modulate(rms_norm(xc, norm1_w[layer]), mc[0], mc[1])

        if last:
            kc = split_heads(hc @ wi[:, K_OFF:V_OFF], RET_HEADS)
            vc = split_heads(hc @ wi[:, V_OFF:G_OFF], RET_HEADS)
            s_f = retention_state(kc, vc, a_f)
            s_b = retention_state(jnp.flip(kc, 2), jnp.flip(vc, 2), a_b)
        else:
            qc, kc, vc, gc, fc = split_proj(hc @ wi)
            qc = split_heads(qc, RET_HEADS) * q_scale
            kc = split_heads(kc, RET_HEADS)
            vc = split_heads(vc, RET_HEADS)
            zeros = jnp.zeros((b, RET_HEADS, RET_QK_DIM, RET_V_DIM), jnp.float32)
            oc, s_f, s_b = bidir_retention(qc, kc, vc, a_f, a_b, zeros, zeros)
            yc = merge_branches(hc, ret_readout(oc, gc, w_ret_out[layer]),
                                fourier_mix(fc, w_four_out[layer]),
                                w_branch_gate[layer], b_branch_gate[layer], w_out[layer])
            xc = xc + mc[2] * yc
            hc2 = modulate(rms_norm(xc, norm2_w[layer]), mc[3], mc[4])
            xc = xc + mc[5] * conv_ffn(hc2, w_up[layer], conv_w[layer], conv_b[layer], w_down[layer])

        q, k, v, g, f = split_proj(h @ wi)
        q = rope_2d(split_heads(q, RET_HEADS), row, col) * q_scale
        k = rope_2d(split_heads(k, RET_HEADS), row, col)
        v = split_heads(v, RET_HEADS)
        o, _, _ = bidir_retention(q, k, v, a_f, a_b, s_f, s_b)
        y = merge_branches(h, ret_readout(o, g, w_ret_out[layer]),
                           fourier_mix(f, w_four_out[layer]),
                           w_branch_gate[layer], b_branch_gate[layer], w_out[layer])
        x = x + g1 * y
        h2 = modulate(rms_norm(x, norm2_w[layer]), sh2, sc2)
        x = x + g2 * conv_ffn(h2, w_up[layer], conv_w[layer], conv_b[layer], w_down[layer])
    return rms_norm(x, final_norm_w)
```

```cpp
#include <hip/hip_runtime.h>
#include <hip/hip_cooperative_groups.h>
#include <cstdio>
#include <cstdint>
namespace cg = cooperative_groups;

#ifndef MK_MULTI
#define MK_MULTI 0
#endif

#define LAS __attribute__((address_space(3)))
typedef unsigned short bf16_t;
typedef short bf16x8 __attribute__((ext_vector_type(8)));
typedef short s16x4 __attribute__((ext_vector_type(4)));
typedef float f32x4 __attribute__((ext_vector_type(4)));
typedef float f32x2 __attribute__((ext_vector_type(2)));
typedef unsigned u32x4 __attribute__((ext_vector_type(4)));
typedef unsigned u32x2 __attribute__((ext_vector_type(2)));

constexpr int D = 1024, NB = 2, SEQ = 8192, M = NB * SEQ, CTX = 256, MC = NB * CTX;
constexpr int NH = 8, DK = 64, DV = 128, CH = 128, NCH = SEQ / CH;
constexpr int INC = 3584, FFN = 2816, NUP = 2 * FFN;
constexpr int NIN = 4096;
constexpr float EPS = 1e-6f;
constexpr int CONV_UNITS_PER_BATCH = 34, CONV_NM = 2 * CONV_UNITS_PER_BATCH;

constexpr size_t MiB = 1u << 20;
constexpr size_t WS_MODV = 0;
constexpr size_t WS_ROPEC = 128 * 1024;
constexpr size_t WS_ROPES = 160 * 1024;
constexpr size_t WS_T8192 = 192 * 1024;
constexpr size_t WS_XBAR = 3 * MiB + 65536;
constexpr size_t WS_KVC = 1 * MiB;
constexpr size_t WS_WIN = 4 * MiB;
constexpr size_t WS_WRO = 12 * MiB;
constexpr size_t WS_WFO = 14 * MiB;
constexpr size_t WS_WBG = 15 * MiB;
constexpr size_t WS_WOUT = 19 * MiB;
constexpr size_t WS_WUP = 21 * MiB;
constexpr size_t WS_WDN = 32 * MiB;
constexpr size_t WS_H = 38 * MiB;
constexpr size_t WS_Q = 72 * MiB;
constexpr size_t WS_K = 88 * MiB;
constexpr size_t WS_V = 104 * MiB;
constexpr size_t WS_G = 136 * MiB;
constexpr size_t WS_F = 168 * MiB;
constexpr size_t WS_Z = 200 * MiB;
constexpr size_t WS_X1 = 72 * MiB;
constexpr size_t WS_RETD = 72 * MiB;
constexpr size_t WS_FOURD = 104 * MiB;
constexpr size_t WS_MERGED = 136 * MiB;
constexpr size_t WS_SPREV = 216 * MiB;
constexpr size_t WS_X2B = 224 * MiB;
constexpr size_t WS_ACT = 136 * MiB;
constexpr size_t DO_KVINC = 0;
constexpr size_t DO_Y = 32 * MiB;
constexpr size_t DO_R = 0;

constexpr int LDS_BYTES = 147456;

typedef __bf16 bf16x2_t __attribute__((ext_vector_type(2)));
__device__ __forceinline__ unsigned cvt_pk_bf16(float lo, float hi) { const f32x2 v = {lo, hi}; const bf16x2_t b = __builtin_convertvector(v, bf16x2_t); return __builtin_bit_cast(unsigned, b); }
__device__ __forceinline__ float bf_lo(unsigned u) { return __uint_as_float(u << 16); }
__device__ __forceinline__ float bf_hi(unsigned u) { return __uint_as_float(u & 0xffff0000u); }
__device__ __forceinline__ float bf2f(bf16_t b) { return __uint_as_float(((unsigned)b) << 16); }
__device__ __forceinline__ float sigmoidf_(float x) { return 1.f / (1.f + __expf(-x)); }
__device__ __forceinline__ float siluf_(float x) { return x / (1.f + __expf(-x)); }
__device__ __forceinline__ float gelu_tanh(float a) { const float u = 0.7978845608028654f * (a + 0.044715f * a * a * a); return a / (1.f + __expf(-2.f * u)); }
template <class T> __device__ __forceinline__ T* at_off(const void* base, unsigned byte_off) { return (T*)((char*)base + byte_off); }
__device__ __forceinline__ int lane_id() { int r; asm volatile("v_mbcnt_lo_u32_b32 %0, -1, 0\n\tv_mbcnt_hi_u32_b32 %0, -1, %0" : "=v"(r)); return r; }
__device__ __forceinline__ float wave_sum(float v) {
#pragma unroll
    for (int o = 1; o < 64; o <<= 1) v += __shfl_xor(v, o);
    return v;
}

namespace pg8 {
constexpr int BM = 256, BK = 64, HALF = 128, HTB = HALF * BK * 2, STAGE_BYTES = 8 * HTB, NXCD = 8, WGM = 8;
__host__ __device__ __forceinline__ int lds_byte(int r, int c) { const int st = (r >> 4) * 2 + (c >> 5), rr = r & 15, cc = c & 31, ob = rr * 64 + cc * 2; return st * 1024 + (ob ^ (((ob >> 9) & 1) << 5)); }
__host__ __device__ __forceinline__ void stage_rc(int b, int& R, int& C) { const int st = b / 1024, sb = b % 1024, swz = sb ^ (((sb >> 9) & 1) << 5); R = (st >> 1) * 16 + swz / 64; C = (st & 1) * 32 + (swz % 64) / 2; }
__host__ __device__ __forceinline__ int perm32(int rho) { const int n = rho >> 4, i = rho & 15; return 8 * (i >> 2) + 4 * n + (i & 3); }

struct Unit { int pm, pn; };
struct Gemm { const bf16_t* A; const bf16_t* Bt; int nM, nN, K; };

struct StaticOrder {
    int nM, nN, nwg, G, c;
    __device__ void init(int nM_, int nN_, int G_, int c_) { nM = nM_; nN = nN_; nwg = nM * nN; G = G_; c = c_; }
    __device__ bool next(int i, Unit& u) const {
        const long L = (long)i * G + c; if (L >= nwg) return false;
        int wgid = (int)L; { const int q = nwg / NXCD, r = nwg % NXCD, xcd = wgid % NXCD, off = wgid / NXCD; wgid = (xcd < r ? xcd * (q + 1) : r * (q + 1) + (xcd - r) * q) + off; }
        const int nig = WGM * nN, gid = wgid / nig, fm = gid * WGM, gsz = (nM - fm) < WGM ? (nM - fm) : WGM;
        u.pm = fm + ((wgid % nig) % gsz); u.pn = (wgid % nig) / gsz; return true;
    }
};

template <bool CONVA> __device__ __forceinline__ const char* a_panel(const Gemm& g, int pm) {
    if constexpr (CONVA) { const int b = pm / CONV_UNITS_PER_BATCH, u = pm % CONV_UNITS_PER_BATCH; return (const char*)g.A + ((long)b * SEQ + 248L * u - 1L) * (long)g.K * 2L; }
    else return (const char*)g.A + (size_t)pm * (size_t)(BM * 2) * g.K;
}

template <class Epi, bool CONVA = false, bool ALIGN_EPI = true, bool SP2 = true>
__device__ __forceinline__ void gemm_phase(LAS unsigned char* lds, const Gemm g, const StaticOrder& S, const Epi& E, const int wv) {
    const int lane = lane_id(), tid = wv * 64 + lane, wid = wv, wr = wid >> 2, wc = wid & 3, fr = lane & 15, fq = lane >> 4;
    const int K = g.K, nt = K / BK;
    unsigned voffA[2], voffB[2];
#pragma unroll
    for (int i = 0; i < 2; ++i) { int R, C; stage_rc(tid * 16 + i * 8192, R, C); const int Rb = Epi::PERM ? ((R & ~31) + perm32(R & 31)) : R;
        const int Ra = CONVA ? ((R >> 6) * 62 + (R & 63)) : R;
        voffA[i] = (unsigned)(Ra * K + C) * 2u; voffB[i] = (unsigned)(Rb * K + C) * 2u; }
    const size_t kstep = (size_t)(BK * 2);
    const size_t hstep = (size_t)HALF * K * 2;
    const size_t hstepA = CONVA ? (size_t)124 * K * 2 : hstep;
    const size_t tstep = 2 * hstep;
    const unsigned ldsw = (unsigned)wid * 1024u;
    const int aoff = lds_byte(wr * 64 + fr, fq * 8), boff = lds_byte(wc * 32 + fr, fq * 8);
#define PG8_SA(b, h) (((b) * 2 + (h)) * HTB)
#define PG8_SB(b, h) ((4 + (b) * 2 + (h)) * HTB)
#define PG8_STAGE(bufoff, gbase, voff) do { _Pragma("unroll") for (int _i = 0; _i < 2; ++_i) \
        __builtin_amdgcn_global_load_lds((const unsigned*)((const char*)(gbase) + (voff)[_i]), (LAS unsigned*)(lds + (bufoff) + ldsw + _i * 8192), 16, 0, 0); } while (0)
#define PG8_LDA(dst, b, h) do { _Pragma("unroll") for (int m = 0; m < 4; ++m) _Pragma("unroll") for (int k = 0; k < 2; ++k) dst[m][k] = *(const LAS bf16x8*)(lds + PG8_SA(b, h) + aoff + m * 2048 + k * 1024); } while (0)
#define PG8_LDB(dst, b, h) do { _Pragma("unroll") for (int n = 0; n < 2; ++n) _Pragma("unroll") for (int k = 0; k < 2; ++k) dst[n][k] = *(const LAS bf16x8*)(lds + PG8_SB(b, h) + boff + n * 2048 + k * 1024); } while (0)
#define PG8_MMA(ai, bj, At, Bt) do { __builtin_amdgcn_s_setprio(1); _Pragma("unroll") for (int m = 0; m < 4; ++m) _Pragma("unroll") for (int n = 0; n < 2; ++n) _Pragma("unroll") for (int k = 0; k < 2; ++k) \
        acc[ai][bj][m][n] = __builtin_amdgcn_mfma_f32_16x16x32_bf16(Bt[n][k], At[m][k], acc[ai][bj][m][n], 0, 0, 0); __builtin_amdgcn_s_setprio(0); } while (0)
#define PG8_WAIT_V(n) asm volatile("s_waitcnt vmcnt(" #n ")" ::: "memory")
#define PG8_WAIT_L(n) asm volatile("s_waitcnt lgkmcnt(" #n ")" ::: "memory")
#define PG8_BAR __builtin_amdgcn_s_barrier()
#define PG8_SCHED __builtin_amdgcn_sched_barrier(0)
    Unit cur, nxt; int ui = 0;
    if (!S.next(0, cur)) return;
    f32x4 acc[2][2][4][2];
#pragma unroll
    for (int a = 0; a < 2; ++a)
#pragma unroll
        for (int b = 0; b < 2; ++b)
#pragma unroll
            for (int m = 0; m < 4; ++m)
#pragma unroll
                for (int n = 0; n < 2; ++n) acc[a][b][m][n] = (f32x4){0.f, 0.f, 0.f, 0.f};
    bf16x8 At[4][2], B0[2][2], B1[2][2];
    const char* cA = a_panel<CONVA>(g, cur.pm); const char* cB = (const char*)g.Bt + (size_t)cur.pn * tstep;
    if constexpr (SP2) {
        PG8_STAGE(PG8_SB(0, 0), cB, voffB); PG8_STAGE(PG8_SB(0, 1), cB + hstep, voffB); PG8_STAGE(PG8_SA(0, 0), cA, voffA); PG8_STAGE(PG8_SA(0, 1), cA + hstepA, voffA);
        if (wr == 1) PG8_BAR;
        PG8_WAIT_V(2); PG8_BAR;
        PG8_STAGE(PG8_SB(1, 0), cB + kstep, voffB); PG8_STAGE(PG8_SA(1, 0), cA + kstep, voffA); PG8_STAGE(PG8_SB(1, 1), cB + hstep + kstep, voffB);
        PG8_WAIT_V(6); PG8_BAR;
    } else {
        PG8_STAGE(PG8_SB(0, 0), cB, voffB); PG8_STAGE(PG8_SA(0, 0), cA, voffA); PG8_STAGE(PG8_SB(0, 1), cB + hstep, voffB); PG8_STAGE(PG8_SA(0, 1), cA + hstepA, voffA);
        if (wr == 1) PG8_BAR;
        PG8_WAIT_V(4); PG8_BAR;
        PG8_STAGE(PG8_SB(1, 0), cB + kstep, voffB); PG8_STAGE(PG8_SA(1, 0), cA + kstep, voffA); PG8_STAGE(PG8_SB(1, 1), cB + hstep + kstep, voffB);
        PG8_WAIT_V(6); PG8_BAR;
    }
    for (;;) {
        const bool has_next = S.next(ui + 1, nxt);
        const char* nA = has_next ? a_panel<CONVA>(g, nxt.pm) : cA; const char* nB = has_next ? (const char*)g.Bt + (size_t)nxt.pn * tstep : cB;
        for (int t = 0; t < nt; t += 2) {
            const bool last = (t == nt - 2);
            const char* a1 = cA + (size_t)(t + 1) * kstep;
            const char* a2 = last ? nA : cA + (size_t)(t + 2) * kstep; const char* b2 = last ? nB : cB + (size_t)(t + 2) * kstep;
            const char* a3 = a2 + kstep; const char* b3 = b2 + kstep;
            if constexpr (SP2) {
            PG8_LDB(B0, 0, 0); PG8_LDB(B1, 0, 1); PG8_SCHED; PG8_LDA(At, 0, 0); PG8_STAGE(PG8_SA(1, 1), a1 + hstepA, voffA);
            PG8_WAIT_V(8); PG8_WAIT_L(0); PG8_BAR; PG8_MMA(0, 0, At, B0); PG8_MMA(0, 1, At, B1); PG8_BAR; PG8_SCHED;
            PG8_LDA(At, 0, 1); PG8_STAGE(PG8_SB(0, 0), b2, voffB); PG8_STAGE(PG8_SB(0, 1), b2 + hstep, voffB); PG8_STAGE(PG8_SA(0, 0), a2, voffA);
            PG8_WAIT_V(8); PG8_WAIT_L(0); PG8_BAR; PG8_MMA(1, 0, At, B0); PG8_MMA(1, 1, At, B1); PG8_BAR; PG8_SCHED;
            PG8_LDB(B0, 1, 0); PG8_LDB(B1, 1, 1); PG8_SCHED; PG8_LDA(At, 1, 0); PG8_STAGE(PG8_SA(0, 1), a2 + hstepA, voffA);
            PG8_WAIT_V(8); PG8_WAIT_L(0); PG8_BAR; PG8_MMA(0, 0, At, B0); PG8_MMA(0, 1, At, B1); PG8_BAR; PG8_SCHED;
            PG8_LDA(At, 1, 1); PG8_STAGE(PG8_SB(1, 0), b3, voffB); PG8_STAGE(PG8_SB(1, 1), b3 + hstep, voffB); PG8_STAGE(PG8_SA(1, 0), a3, voffA);
            PG8_WAIT_V(8); PG8_WAIT_L(0); PG8_BAR; PG8_MMA(1, 0, At, B0); PG8_MMA(1, 1, At, B1); PG8_BAR; PG8_SCHED;
            } else {
            PG8_LDB(B0, 0, 0); PG8_SCHED; PG8_LDA(At, 0, 0); PG8_STAGE(PG8_SA(1, 1), a1 + hstepA, voffA);
            PG8_WAIT_L(8); PG8_BAR; PG8_WAIT_L(0); PG8_MMA(0, 0, At, B0); PG8_BAR; PG8_SCHED;
            PG8_LDB(B1, 0, 1); PG8_STAGE(PG8_SB(0, 0), b2, voffB);
            PG8_BAR; PG8_WAIT_L(0); PG8_MMA(0, 1, At, B1); PG8_BAR;
            PG8_LDA(At, 0, 1); PG8_STAGE(PG8_SA(0, 0), a2, voffA);
            PG8_BAR; PG8_WAIT_L(0); PG8_MMA(1, 0, At, B0); PG8_BAR; PG8_SCHED;
            PG8_STAGE(PG8_SB(0, 1), b2 + hstep, voffB);
            PG8_WAIT_V(6); PG8_BAR; PG8_MMA(1, 1, At, B1); PG8_BAR;
            PG8_LDB(B0, 1, 0); PG8_SCHED; PG8_LDA(At, 1, 0); PG8_STAGE(PG8_SA(0, 1), a2 + hstepA, voffA);
            PG8_WAIT_L(8); PG8_BAR; PG8_WAIT_L(0); PG8_MMA(0, 0, At, B0); PG8_BAR; PG8_SCHED;
            PG8_LDB(B1, 1, 1); PG8_STAGE(PG8_SB(1, 0), b3, voffB);
            PG8_BAR; PG8_WAIT_L(0); PG8_MMA(0, 1, At, B1); PG8_BAR;
            PG8_LDA(At, 1, 1); PG8_STAGE(PG8_SA(1, 0), a3, voffA);
            PG8_BAR; PG8_WAIT_L(0); PG8_MMA(1, 0, At, B0); PG8_BAR; PG8_SCHED;
            PG8_STAGE(PG8_SB(1, 1), b3 + hstep, voffB);
            PG8_WAIT_V(6); PG8_BAR; PG8_MMA(1, 1, At, B1); PG8_BAR;
            }
        }
        if constexpr (ALIGN_EPI) { if (wr == 0) PG8_BAR; }
        E(acc, cur, wr, wc, fr, fq);
        if (!has_next) break;
#pragma unroll
        for (int a = 0; a < 2; ++a)
#pragma unroll
            for (int b = 0; b < 2; ++b)
#pragma unroll
                for (int m = 0; m < 4; ++m)
#pragma unroll
                    for (int n = 0; n < 2; ++n) acc[a][b][m][n] = (f32x4){0.f, 0.f, 0.f, 0.f};
        cur = nxt; cA = nA; cB = nB; ++ui;
        if constexpr (ALIGN_EPI) { if (wr == 1) PG8_BAR; }
    }
    PG8_WAIT_V(0);
    if constexpr (!ALIGN_EPI) { if (wr == 0) PG8_BAR; }
    PG8_BAR;
#undef PG8_SA
#undef PG8_SB
#undef PG8_STAGE
#undef PG8_LDA
#undef PG8_LDB
#undef PG8_MMA
#undef PG8_WAIT_V
#undef PG8_WAIT_L
#undef PG8_BAR
#undef PG8_SCHED
}
}
using pg8::Unit;

typedef f32x4 Acc[2][2][4][2];

struct EpiInProj {
    static constexpr bool PERM = true;
    bf16_t *q, *k, *v, *g, *f; const float* ropec; const float* ropes;
    __device__ __forceinline__ void operator()(const Acc& acc, const Unit& u, int wr, int wc, int fr, int fq) const {
        const int pn = u.pn; bf16_t* base; int ldc, colt;
        if (pn < 2) { base = q; ldc = 512; colt = pn * 256; }
        else if (pn < 4) { base = k; ldc = 512; colt = (pn - 2) * 256; }
        else if (pn < 8) { base = v; ldc = 1024; colt = (pn - 4) * 256; }
        else if (pn < 12) { base = g; ldc = 1024; colt = (pn - 8) * 256; }
        else { base = f; ldc = 1024; colt = (pn - 12) * 256; }
        const bool rope = pn < 4;
        const int row0 = u.pm * 256 + wr * 64 + fr, col0 = colt + wc * 32 + 8 * fq;
#pragma unroll
        for (int ai = 0; ai < 2; ++ai)
#pragma unroll
            for (int m = 0; m < 4; ++m) {
                const int row = row0 + ai * 128 + m * 16;
                f32x4 cs = (f32x4){1.f, 1.f, 1.f, 1.f}, sn = (f32x4){0.f, 0.f, 0.f, 0.f};
                if (rope) { const int l = row & (SEQ - 1); const int p = (wc & 1) ? (l & 63) : (l >> 6); cs = *(const f32x4*)(ropec + p * 16 + 4 * fq); sn = *(const f32x4*)(ropes + p * 16 + 4 * fq); }
                bf16_t* rowp = base + (size_t)row * ldc + col0;
#pragma unroll
                for (int bj = 0; bj < 2; ++bj) {
                    const f32x4 t1 = acc[ai][bj][m][0], t2 = acc[ai][bj][m][1];
                    const f32x4 o1 = t1 * cs - t2 * sn, o2 = t1 * sn + t2 * cs;
                    u32x4 o; o.x = cvt_pk_bf16(o1[0], o1[1]); o.y = cvt_pk_bf16(o1[2], o1[3]); o.z = cvt_pk_bf16(o2[0], o2[1]); o.w = cvt_pk_bf16(o2[2], o2[3]);
                    *(u32x4*)(rowp + bj * 128) = o;
                }
            }
    }
};

struct EpiBf16 {
    static constexpr bool PERM = true;
    bf16_t* O; int ldc;
    __device__ __forceinline__ void operator()(const Acc& acc, const Unit& u, int wr, int wc, int fr, int fq) const {
        const int row0 = u.pm * 256 + wr * 64 + fr, col0 = u.pn * 256 + wc * 32 + 8 * fq;
#pragma unroll
        for (int ai = 0; ai < 2; ++ai)
#pragma unroll
            for (int m = 0; m < 4; ++m) {
                bf16_t* rowp = O + (size_t)(row0 + ai * 128 + m * 16) * ldc + col0;
#pragma unroll
                for (int bj = 0; bj < 2; ++bj) {
                    const f32x4 v0 = acc[ai][bj][m][0], v1 = acc[ai][bj][m][1];
                    u32x4 o; o.x = cvt_pk_bf16(v0[0], v0[1]); o.y = cvt_pk_bf16(v0[2], v0[3]); o.z = cvt_pk_bf16(v1[0], v1[1]); o.w = cvt_pk_bf16(v1[2], v1[3]);
                    *(u32x4*)(rowp + bj * 128) = o;
                }
            }
    }
};

struct EpiMerge {
    static constexpr bool PERM = true;
    const bf16_t* retd; const bf16_t* fourd; const float* bbg; bf16_t* merged;
    __device__ __forceinline__ void operator()(const Acc& acc, const Unit& u, int wr, int wc, int fr, int fq) const {
        const int row0 = u.pm * 256 + wr * 64 + fr, ch0 = u.pn * 128 + wc * 16 + 4 * fq;
        f32x4 br[2], bf[2];
#pragma unroll
        for (int bj = 0; bj < 2; ++bj) { br[bj] = *(const f32x4*)(bbg + ch0 + 64 * bj); bf[bj] = *(const f32x4*)(bbg + D + ch0 + 64 * bj); }
#pragma unroll
        for (int ai = 0; ai < 2; ++ai)
#pragma unroll
            for (int m = 0; m < 4; ++m) {
                const size_t ro = (size_t)(row0 + ai * 128 + m * 16) * D + ch0;
#pragma unroll
                for (int bj = 0; bj < 2; ++bj) {
                    const f32x4 a = acc[ai][bj][m][0] + br[bj], b = acc[ai][bj][m][1] + bf[bj];
                    const u32x2 rd = *(const u32x2*)(retd + ro + 64 * bj), fd = *(const u32x2*)(fourd + ro + 64 * bj);
                    const float o0 = sigmoidf_(a[0]) * bf_lo(rd.x) + sigmoidf_(b[0]) * bf_lo(fd.x);
                    const float o1 = sigmoidf_(a[1]) * bf_hi(rd.x) + sigmoidf_(b[1]) * bf_hi(fd.x);
                    const float o2 = sigmoidf_(a[2]) * bf_lo(rd.y) + sigmoidf_(b[2]) * bf_lo(fd.y);
                    const float o3 = sigmoidf_(a[3]) * bf_hi(rd.y) + sigmoidf_(b[3]) * bf_hi(fd.y);
                    u32x2 o; o.x = cvt_pk_bf16(o0, o1); o.y = cvt_pk_bf16(o2, o3);
                    *(u32x2*)(merged + ro + 64 * bj) = o;
                }
            }
    }
};

template <bool XIN_BF, bool OUT_BF> struct EpiResidT {
    static constexpr bool PERM = false;
    const void* xin; const float* gate; void* out;
    __device__ __forceinline__ void operator()(const Acc& acc, const Unit& u, int wr, int wc, int fr, int fq) const {
        const int row0 = u.pm * 256 + wr * 64 + fr, col0 = u.pn * 256 + wc * 32 + 4 * fq;
        const int b = (u.pm * 256) >> 13;
        f32x4 gv[2][2];
#pragma unroll
        for (int bj = 0; bj < 2; ++bj)
#pragma unroll
            for (int n = 0; n < 2; ++n) gv[bj][n] = *(const f32x4*)(gate + b * 6144 + col0 + bj * 128 + n * 16);
#pragma unroll
        for (int ai = 0; ai < 2; ++ai)
#pragma unroll
            for (int m = 0; m < 4; ++m) {
                const size_t ro = (size_t)(row0 + ai * 128 + m * 16) * D + col0;
#pragma unroll
                for (int bj = 0; bj < 2; ++bj)
#pragma unroll
                    for (int n = 0; n < 2; ++n) {
                        const size_t o_ = ro + bj * 128 + n * 16;
                        f32x4 xv;
                        if constexpr (XIN_BF) { const u32x2 q = *(const u32x2*)((const bf16_t*)xin + o_); xv = (f32x4){bf_lo(q.x), bf_hi(q.x), bf_lo(q.y), bf_hi(q.y)}; }
                        else xv = *(const f32x4*)((const float*)xin + o_);
                        const f32x4 r = xv + gv[bj][n] * acc[ai][bj][m][n];
                        if constexpr (OUT_BF) { u32x2 w; w.x = cvt_pk_bf16(r[0], r[1]); w.y = cvt_pk_bf16(r[2], r[3]); *(u32x2*)((bf16_t*)out + o_) = w; }
                        else *(f32x4*)((float*)out + o_) = r;
                    }
            }
    }
};
typedef EpiResidT<false, false> EpiResid;

struct EpiUpConv {
    static constexpr bool PERM = true;
    const float* convw; const float* convb; bf16_t* act; LAS float* wl;
    __device__ __forceinline__ void operator()(const Acc& acc, const Unit& u, int wr, int wc, int, int) const {
        const int ln_ = lane_id(), fr = ln_ & 15, fq = ln_ >> 4;
        const int b = u.pm / CONV_UNITS_PER_BATCH, up = u.pm % CONV_UNITS_PER_BATCH;
        const int ch0 = u.pn * 128 + wc * 32 + 8 * fq;
        if (wr == 0) { const int te = wc * 64 + (fq * 16 + fr), src = (te >> 7) * FFN + u.pn * 128 + (te & 127);
            wl[te] = convw[src]; wl[256 + te] = convw[NUP + src]; wl[512 + te] = convw[2 * NUP + src]; wl[768 + te] = convb[src]; }
        asm volatile("s_waitcnt lgkmcnt(0)" ::: "memory");
        __builtin_amdgcn_s_barrier();
        asm volatile("" ::: "memory");
#pragma unroll
        for (int n = 0; n < 2; ++n) {
            const int ch = ch0 + 4 * n;
#pragma unroll
            for (int ai = 0; ai < 2; ++ai) {
                const int j = 4 * up + 2 * ai + wr;
                const int t0 = 62 * j - 1 + fr;
                f32x4 ua[4];
#ifdef DBG_RAWUP
                f32x4 dbg_xp[4], dbg_xn[4];
#endif
                __builtin_amdgcn_sched_barrier(0);
#pragma unroll
                for (int part = 0; part < 2; ++part) {
                    __builtin_amdgcn_sched_barrier(0);
                    const LAS float* cw = wl + part * 128 + wc * 32 + 8 * fq + 4 * n;
                    const f32x4 w0 = *(const LAS f32x4*)(cw), w1 = *(const LAS f32x4*)(cw + 256), w2 = *(const LAS f32x4*)(cw + 512), bb = *(const LAS f32x4*)(cw + 768);
                    f32x4 xv[4];
#pragma unroll
                    for (int m = 0; m < 4; ++m) { const int t = t0 + 16 * m; const bool ok = (t >= 0) && (t < SEQ); xv[m] = ok ? acc[ai][part][m][n] : (f32x4){0.f, 0.f, 0.f, 0.f}; }
                    f32x4 x1[4];
#pragma unroll
                    for (int m = 0; m < 4; ++m)
#pragma unroll
                        for (int e = 0; e < 4; ++e) {
                            const float prv = xv[m > 0 ? m - 1 : 0][e], cur = xv[m][e];
                            const int e0 = __builtin_amdgcn_update_dpp(0, __float_as_int(prv), 0x10f, 0xf, 0xf, false);
                            x1[m][e] = __int_as_float(__builtin_amdgcn_update_dpp(e0, __float_as_int(cur), 0x111, 0xf, 0xf, false));
                        }
#pragma unroll
                    for (int m = 0; m < 4; ++m) {
                        f32x4 x2;
#pragma unroll
                        for (int e = 0; e < 4; ++e) {
                            const float prv = x1[m > 0 ? m - 1 : 0][e], cur = x1[m][e];
                            const int e0 = __builtin_amdgcn_update_dpp(0, __float_as_int(prv), 0x10f, 0xf, 0xf, false);
                            x2[e] = __int_as_float(__builtin_amdgcn_update_dpp(e0, __float_as_int(cur), 0x111, 0xf, 0xf, false));
                        }
                        const f32x4 uu = w0 * x2 + w1 * x1[m] + w2 * xv[m] + bb;
#ifdef DBG_RAWUP
                        if (part == 0) { dbg_xp[m] = x1[m]; dbg_xn[m] = x2; }
#endif
                        if (part == 0) ua[m] = uu;
                        else {
                            const int r = 16 * m + fr, t = t0 + 16 * m - 1;
                            if (r >= 2 && t < SEQ) {
                                u32x2 o; o.x = cvt_pk_bf16(gelu_tanh(ua[m][0]) * uu[0], gelu_tanh(ua[m][1]) * uu[1]); o.y = cvt_pk_bf16(gelu_tanh(ua[m][2]) * uu[2], gelu_tanh(ua[m][3]) * uu[3]);
#ifdef DBG_RAWUP
                                { o.x = cvt_pk_bf16(dbg_xp[m][0], dbg_xp[m][1]); o.y = cvt_pk_bf16(dbg_xn[m][2], dbg_xn[m][3]); }
#endif
                                *at_off<u32x2>(act, 2u * (unsigned)((b * SEQ + t) * FFN + ch)) = o;
                            }
                        }
                    }
                }
            }
        }
    }
};

struct Params {
    const float *x, *c, *ctx, *c_ctx, *w_mod, *b_mod, *norm1_w, *w_in, *dec_f, *dec_b, *w_ro, *w_fo, *w_bg, *b_bg, *w_out, *norm2_w, *w_up, *conv_w, *conv_b, *w_down, *fnorm_w;
    float* out; unsigned char* ws;
    int ph_lo, ph_hi;
};

template <int MAP> __device__ __forceinline__ int dst_row(int n) {
    if constexpr (MAP == 1) {
        if (n < 1024) { const int hd = n & ~63, d = n & 63, part = d >> 5, i = d & 31; return hd + (i >> 2) * 8 + part * 4 + (i & 3); }
        return n;
    } else if constexpr (MAP == 2) {
        const int br = n >> 10, ch = n & 1023; return (ch >> 2) * 8 + br * 4 + (ch & 3);
    } else if constexpr (MAP == 3) {
        const int part = n >= FFN ? 1 : 0, ch = n - part * FFN; return (ch >> 7) * 256 + part * 128 + (ch & 127);
    } else return n;
}
template <int MAP> __device__ __forceinline__ void transpose_item(const float* W, int K, int ldn, int nblk, bf16_t* WT, LAS float* scr, int item, int lane) {
    const int kb = item / nblk, nb = item % nblk, k0 = 64 * kb, n0 = 32 * nb;
#pragma unroll 8
    for (int i = 0; i < 32; ++i) { const int kk = 2 * i + (lane >> 5); scr[kk * 33 + (lane & 31)] = W[(size_t)(k0 + kk) * ldn + n0 + (lane & 31)]; }
    asm volatile("s_waitcnt lgkmcnt(0)" ::: "memory");
    const int c = lane & 7;
#pragma unroll
    for (int j = 0; j < 4; ++j) { const int n = (lane >> 3) + 8 * j; const LAS float* s = scr + (8 * c) * 33 + n;
        const float sc = (MAP == 1 && (n0 + n) < 512) ? 0.125f : 1.f;
        u32x4 o; o.x = cvt_pk_bf16(s[0 * 33] * sc, s[1 * 33] * sc); o.y = cvt_pk_bf16(s[2 * 33] * sc, s[3 * 33] * sc); o.z = cvt_pk_bf16(s[4 * 33] * sc, s[5 * 33] * sc); o.w = cvt_pk_bf16(s[6 * 33] * sc, s[7 * 33] * sc);
        *(u32x4*)(WT + (size_t)dst_row<MAP>(n0 + n) * K + k0 + 8 * c) = o; }
    asm volatile("s_waitcnt lgkmcnt(0)" ::: "memory");
}

__device__ __forceinline__ void phase_prep(const Params& p, LAS unsigned char* lds, const int wv) {
    const int lane = lane_id(), wave = wv, tid = wv * 64 + lane;
    const int gw = blockIdx.x * 8 + wave, NGW = gridDim.x * 8;
    unsigned char* ws = p.ws;
    {
        const int gt = blockIdx.x * 512 + tid;
        if (gt < 2048) { const int pp = gt >> 4, f = gt & 15; const float inv = exp2f(-(float)f * (13.287712379549449f / 16.f)); const float ang = (float)pp * inv;
            float rev = ang * 0.15915494309189535f; rev -= floorf(rev);
            ((float*)(ws + WS_ROPEC))[gt] = cospif(2.f * rev); ((float*)(ws + WS_ROPES))[gt] = sinpif(2.f * rev); }
        if (gt < 8192) ((float*)(ws + WS_T8192))[gt] = cospif((float)gt * (1.f / 4096.f));
    }
    {
        LAS float* scr = (LAS float*)(lds + wave * 16384);
        constexpr int I1 = 16 * 96, I2 = 16 * 32, I3 = 8 * 32, I4 = 16 * 64, I5 = 16 * 32, I6 = 16 * 176, I7 = 44 * 32;
        constexpr int NIT = I1 + I2 + I3 + I4 + I5 + I6 + I7;
        for (int it = gw; it < NIT; it += NGW) {
            int r = it;
            if (r < I1) { transpose_item<1>(p.w_in, 1024, INC, 96, (bf16_t*)(ws + WS_WIN), scr, r, lane); continue; } r -= I1;
            if (r < I2) { transpose_item<0>(p.w_ro, 1024, 1024, 32, (bf16_t*)(ws + WS_WRO), scr, r, lane); continue; } r -= I2;
            if (r < I3) { transpose_item<0>(p.w_fo, 512, 1024, 32, (bf16_t*)(ws + WS_WFO), scr, r, lane); continue; } r -= I3;
            if (r < I4) { transpose_item<2>(p.w_bg, 1024, 2048, 64, (bf16_t*)(ws + WS_WBG), scr, r, lane); continue; } r -= I4;
            if (r < I5) { transpose_item<0>(p.w_out, 1024, 1024, 32, (bf16_t*)(ws + WS_WOUT), scr, r, lane); continue; } r -= I5;
            if (r < I6) { transpose_item<3>(p.w_up, 1024, NUP, 176, (bf16_t*)(ws + WS_WUP), scr, r, lane); continue; } r -= I6;
            transpose_item<0>(p.w_down, FFN, 1024, 32, (bf16_t*)(ws + WS_WDN), scr, r, lane);
        }
    }
    __syncthreads();
    {
        LAS float* wt = (LAS float*)lds;
        LAS float* tab = (LAS float*)(lds + 32 * 129 * 4);
        if (tid < 128) tab[tid] = cospif((float)tid * (1.f / 64.f));
        bf16_t* WT = (bf16_t*)(ws + WS_WIN);
        for (int it = blockIdx.x; it < 256; it += gridDim.x) {
            const int kb = it >> 3, g = (it >> 1) & 3, hf = it & 1;
            __syncthreads();
#pragma unroll
            for (int i = 0; i < 8; ++i) { const int idx = tid + 512 * i, kk = idx >> 7, cc = idx & 127; wt[kk * 129 + cc] = p.w_in[(size_t)(kb * 32 + kk) * INC + 3072 + g * 128 + cc]; }
            __syncthreads();
            const int k = tid & 31, cg4 = tid >> 5, cp0 = hf * 64 + cg4 * 4;
            float aC[4] = {0.f, 0.f, 0.f, 0.f}, aS[4] = {0.f, 0.f, 0.f, 0.f};
            float cr[4], sr[4], ct[4], st[4];
#pragma unroll
            for (int e = 0; e < 4; ++e) { cr[e] = 1.f; sr[e] = 0.f; ct[e] = cospif((float)(cp0 + e) * (1.f / 64.f)); st[e] = sinpif((float)(cp0 + e) * (1.f / 64.f)); }
            for (int cc = 0; cc < 128; ++cc) {
                const float w = wt[k * 129 + cc];
#pragma unroll
                for (int e = 0; e < 4; ++e) { aC[e] += w * cr[e]; aS[e] += w * sr[e]; const float nc = cr[e] * ct[e] - sr[e] * st[e], ns = sr[e] * ct[e] + cr[e] * st[e]; cr[e] = nc; sr[e] = ns; }
            }
#pragma unroll
            for (int e = 0; e < 4; ++e) {
                const int n = g * 128 + cp0 + e;
                WT[(size_t)(3072 + n) * 1024 + kb * 32 + k] = (bf16_t)(cvt_pk_bf16(aC[e] * 0.0625f, 0.f) & 0xffffu);
                WT[(size_t)(3584 + n) * 1024 + kb * 32 + k] = (bf16_t)(cvt_pk_bf16(-aS[e] * 0.0625f, 0.f) & 0xffffu);
            }
        }
        __syncthreads();
    }
    {
        LAS float* sl = (LAS float*)lds;
        LAS float* red = (LAS float*)(lds + 16384);
        if (blockIdx.x < 96) {
#pragma unroll
            for (int i = 0; i < 6; ++i) { const int idx = tid + 512 * i; sl[idx] = siluf_(idx < 2048 ? p.c[idx] : p.c_ctx[idx - 2048]); }
        }
        __syncthreads();
        for (int it = blockIdx.x; it < 96; it += gridDim.x) {
            const int col = it * 64 + lane;
            float a0 = 0.f, a1 = 0.f, a2 = 0.f;
            const float* wp = p.w_mod + (size_t)(wave * 128) * 6144 + col;
#pragma unroll 16
            for (int kk = 0; kk < 128; ++kk) {
                const float wv = wp[(size_t)kk * 6144]; const int k = wave * 128 + kk;
                a0 += sl[k] * wv; a1 += sl[1024 + k] * wv; a2 += sl[2048 + k] * wv;
            }
            __syncthreads();
            red[(wave * 3 + 0) * 64 + lane] = a0; red[(wave * 3 + 1) * 64 + lane] = a1; red[(wave * 3 + 2) * 64 + lane] = a2;
            __syncthreads();
            if (wave < 3) { float sres = p.b_mod[col];
#pragma unroll
                for (int w = 0; w < 8; ++w) sres += red[(w * 3 + wave) * 64 + lane];
                ((float*)(ws + WS_MODV))[wave * 6144 + col] = sres; }
        }
        __syncthreads();
    }
}

template <int MODE> __device__ __forceinline__ void norm_row(const float* xrow, const float* w, const float* sc, const float* sh, void* orow, int lane) {
    const f32x4* xr = (const f32x4*)xrow + lane;
    f32x4 v[4]; float s = 0.f;
#pragma unroll
    for (int j = 0; j < 4; ++j) { v[j] = xr[64 * j]; s += (v[j][0] * v[j][0] + v[j][1] * v[j][1]) + (v[j][2] * v[j][2] + v[j][3] * v[j][3]); }
    const float rs = rsqrtf(wave_sum(s) * (1.f / D) + EPS);
#pragma unroll
    for (int j = 0; j < 4; ++j) {
        const int c = 4 * lane + 256 * j;
        f32x4 y = v[j] * rs * *(const f32x4*)(w + c);
        if constexpr (MODE == 0) {
            y = y * (*(const f32x4*)(sc + c) + 1.f) + *(const f32x4*)(sh + c);
            u32x2 o; o.x = cvt_pk_bf16(y[0], y[1]); o.y = cvt_pk_bf16(y[2], y[3]);
            *(u32x2*)((bf16_t*)orow + c) = o;
        } else {
#ifdef NAN_PROBE
#pragma unroll
            for (int e = 0; e < 4; ++e) if (!(fabsf(y[e]) < 1e30f)) y[e] = 1000.f;
#endif
            *(f32x4*)((float*)orow + c) = y; }
    }
}

template <int MODE> __device__ __forceinline__ void norm_row2(const float* x0, const float* x1, const float* w, const float* sc0, const float* sh0, const float* sc1, const float* sh1, void* o0, void* o1, bool rvalid1, int lane) {
    const f32x4* xr0 = (const f32x4*)x0 + lane; const f32x4* xr1 = (const f32x4*)(rvalid1 ? x1 : x0) + lane;
    f32x4 v0[4], v1[4]; float s0 = 0.f, s1 = 0.f;
#pragma unroll
    for (int j = 0; j < 4; ++j) { v0[j] = xr0[64 * j]; v1[j] = xr1[64 * j]; }
#pragma unroll
    for (int j = 0; j < 4; ++j) { s0 += (v0[j][0] * v0[j][0] + v0[j][1] * v0[j][1]) + (v0[j][2] * v0[j][2] + v0[j][3] * v0[j][3]); s1 += (v1[j][0] * v1[j][0] + v1[j][1] * v1[j][1]) + (v1[j][2] * v1[j][2] + v1[j][3] * v1[j][3]); }
#pragma unroll
    for (int o = 1; o < 64; o <<= 1) { s0 += __shfl_xor(s0, o); s1 += __shfl_xor(s1, o); }
    const float rs0 = rsqrtf(s0 * (1.f / D) + EPS), rs1 = rsqrtf(s1 * (1.f / D) + EPS);
#pragma unroll
    for (int j = 0; j < 4; ++j) {
        const int c = 4 * lane + 256 * j; const f32x4 wv = *(const f32x4*)(w + c);
        f32x4 y0 = v0[j] * rs0 * wv, y1 = v1[j] * rs1 * wv;
        if constexpr (MODE == 0) {
            y0 = y0 * (*(const f32x4*)(sc0 + c) + 1.f) + *(const f32x4*)(sh0 + c); y1 = y1 * (*(const f32x4*)(sc1 + c) + 1.f) + *(const f32x4*)(sh1 + c);
            u32x2 a; a.x = cvt_pk_bf16(y0[0], y0[1]); a.y = cvt_pk_bf16(y0[2], y0[3]); *(u32x2*)((bf16_t*)o0 + c) = a;
            if (rvalid1) { u32x2 bq; bq.x = cvt_pk_bf16(y1[0], y1[1]); bq.y = cvt_pk_bf16(y1[2], y1[3]); *(u32x2*)((bf16_t*)o1 + c) = bq; }
        } else { *(f32x4*)((float*)o0 + c) = y0; if (rvalid1) *(f32x4*)((float*)o1 + c) = y1; }
    }
}

__device__ __forceinline__ bf16x8 tr_frag(LAS unsigned char* tile, int rs, int row0, int col0, int lane) {
    const int g = lane >> 4, q = (lane & 15) >> 2, pp = lane & 3;
    LAS unsigned char* a = tile + (row0 + 8 * g + q) * rs + (col0 + 4 * pp) * 2;
    const s16x4 lo = __builtin_amdgcn_ds_read_tr16_b64_v4i16((LAS s16x4*)a);
    const s16x4 hi = __builtin_amdgcn_ds_read_tr16_b64_v4i16((LAS s16x4*)(a + 4 * rs));
    return __builtin_shufflevector(lo, hi, 0, 1, 2, 3, 4, 5, 6, 7);
}
__device__ __forceinline__ bf16x8 row_frag(LAS unsigned char* tile, int rs, int row0, int col0, int lane) {
    return *(const LAS bf16x8*)(tile + (row0 + (lane & 15)) * rs + (col0 + 8 * (lane >> 4)) * 2);
}
__device__ __forceinline__ bf16x8 scale_frag(bf16x8 v, float s) {
    const u32x4 u = __builtin_bit_cast(u32x4, v); u32x4 o;
    o.x = cvt_pk_bf16(bf_lo(u.x) * s, bf_hi(u.x) * s); o.y = cvt_pk_bf16(bf_lo(u.y) * s, bf_hi(u.y) * s);
    o.z = cvt_pk_bf16(bf_lo(u.z) * s, bf_hi(u.z) * s); o.w = cvt_pk_bf16(bf_lo(u.w) * s, bf_hi(u.w) * s);
    return __builtin_bit_cast(bf16x8, o);
}
template <int ROWS, int COLS> __device__ __forceinline__ void stage_load(u32x4 (&v)[ROWS * COLS / 8 / 512], const bf16_t* src, size_t gld, int tid) {
    constexpr int CPR = COLS / 8, N = ROWS * CPR / 512;
#pragma unroll
    for (int i = 0; i < N; ++i) { const int id = tid + 512 * i, r = id / CPR, c = id % CPR; v[i] = *(const u32x4*)(src + (size_t)r * gld + c * 8); }
}
template <int ROWS, int COLS> __device__ __forceinline__ void stage_store(LAS unsigned char* dst, int rs, const u32x4 (&v)[ROWS * COLS / 8 / 512], int tid) {
    constexpr int CPR = COLS / 8, N = ROWS * CPR / 512;
#pragma unroll
    for (int i = 0; i < N; ++i) { const int id = tid + 512 * i, r = id / CPR, c = id % CPR; *(LAS u32x4*)(dst + r * rs + c * 16) = v[i]; }
}
template <int ROWS, int COLS> __device__ __forceinline__ void stage_tile(LAS unsigned char* dst, int rs, const bf16_t* src, size_t gld, int tid) {
    static_assert((ROWS * COLS / 8) % 512 == 0, "tile pieces must divide over 512 threads");
    u32x4 v[ROWS * COLS / 8 / 512];
    stage_load<ROWS, COLS>(v, src, gld, tid); stage_store<ROWS, COLS>(dst, rs, v, tid);
}

constexpr int RSK = 144, RSV = 272;

__device__ __forceinline__ void phase_kvinc(const Params& p, LAS unsigned char* lds, const int wv, const int it_lo, const int it_hi, const int it_step) {
    const int lane = lane_id(), wave = wv, tid = wv * 64 + lane;
    const bf16_t* kb = (const bf16_t*)(p.ws + WS_K); const bf16_t* vb = (const bf16_t*)(p.ws + WS_V);
    bf16_t* kvinc = (bf16_t*)((unsigned char*)p.out + DO_KVINC);
    LAS unsigned char* Kf = lds; LAS unsigned char* Kb = lds + 128 * RSK; LAS unsigned char* Vt = lds + 2 * 128 * RSK;
    for (int it = it_lo; it < it_hi; it += it_step) {
        const int bh = it >> 6, n = it & 63, b = bh >> 3, h = bh & 7;
        const size_t tok0 = (size_t)b * SEQ + (size_t)n * CH;
        const float lgf = -__expf(p.dec_f[h]) * 1.4426950408889634f, lgb = -__expf(p.dec_b[h]) * 1.4426950408889634f;
        __syncthreads();
#pragma unroll
        for (int i = 0; i < 2; ++i) { const int id = tid + 512 * i, r = id >> 3, c = id & 7;
            const bf16x8 kv = *(const bf16x8*)(kb + (tok0 + r) * 512 + h * 64 + c * 8);
            *(LAS bf16x8*)(Kf + r * RSK + c * 16) = scale_frag(kv, exp2f(lgf * (float)(127 - r)));
            *(LAS bf16x8*)(Kb + r * RSK + c * 16) = scale_frag(kv, exp2f(lgb * (float)r)); }
        stage_tile<128, 128>(Vt, RSV, vb + tok0 * 1024 + h * 128, 1024, tid);
        __syncthreads();
        const int dir = wave >> 2, nt0 = 2 * (wave & 3);
        LAS unsigned char* Kd = dir ? Kb : Kf;
        f32x4 acc[4][2];
#pragma unroll
        for (int m = 0; m < 4; ++m) { acc[m][0] = (f32x4){0.f, 0.f, 0.f, 0.f}; acc[m][1] = (f32x4){0.f, 0.f, 0.f, 0.f}; }
#pragma unroll
        for (int ks = 0; ks < 4; ++ks) {
            const bf16x8 b0 = tr_frag(Vt, RSV, 32 * ks, 16 * nt0, lane), b1 = tr_frag(Vt, RSV, 32 * ks, 16 * nt0 + 16, lane);
#pragma unroll
            for (int m = 0; m < 4; ++m) { const bf16x8 a = tr_frag(Kd, RSK, 32 * ks, 16 * m, lane);
                acc[m][0] = __builtin_amdgcn_mfma_f32_16x16x32_bf16(a, b0, acc[m][0], 0, 0, 0);
                acc[m][1] = __builtin_amdgcn_mfma_f32_16x16x32_bf16(a, b1, acc[m][1], 0, 0, 0); }
        }
        bf16_t* o = kvinc + ((size_t)it * 2 + dir) * 8192;
#pragma unroll
        for (int m = 0; m < 4; ++m)
#pragma unroll
            for (int j = 0; j < 2; ++j) { const int dv = 16 * (nt0 + j) + (lane & 15), dk = 16 * m + 4 * (lane >> 4);
                u32x2 w; w.x = cvt_pk_bf16(acc[m][j][0], acc[m][j][1]); w.y = cvt_pk_bf16(acc[m][j][2], acc[m][j][3]);
                *(u32x2*)(o + dv * 64 + dk) = w; }
    }
}

__device__ __forceinline__ void phase_scan(const Params& p, const int wv) {
    const int tid = wv * 64 + lane_id();
    const bf16_t* kvc = (const bf16_t*)(p.ws + WS_KVC);
    const bf16_t* kvinc = (const bf16_t*)((unsigned char*)p.out + DO_KVINC);
    bf16_t* sprev = (bf16_t*)(p.ws + WS_SPREV);
    for (int it = blockIdx.x; it < 256; it += gridDim.x) {
        const int bh = it >> 4, dir = (it >> 3) & 1, sl = it & 7, b = bh >> 3, h = bh & 7;
        const int dv = 16 * sl + (tid >> 5), dk = 2 * (tid & 31);
        const float a = dir ? p.dec_b[h] : p.dec_f[h];
        const float lg = -__expf(a), gam = __expf(lg), gamC = __expf(lg * (float)CH);
        float s0 = 0.f, s1 = 0.f;
#pragma unroll 32
        for (int jj = 0; jj < CTX; ++jj) {
            const int j = dir ? (CTX - 1 - jj) : jj;
            const bf16_t* row = kvc + (size_t)(b * CTX + j) * 1536;
            const unsigned kk = *(const unsigned*)(row + h * 64 + dk); const float vv = bf2f(row[512 + h * 128 + dv]);
            s0 = gam * s0 + bf_lo(kk) * vv; s1 = gam * s1 + bf_hi(kk) * vv;
        }
#pragma unroll 16
        for (int nn = 0; nn < NCH; ++nn) {
            const int n = dir ? (NCH - 1 - nn) : nn;
            const size_t off = (((size_t)bh * NCH + n) * 2 + dir) * 8192 + dv * 64 + dk;
            const unsigned inc = *(const unsigned*)(kvinc + off);
            *(unsigned*)(sprev + off) = cvt_pk_bf16(s0, s1);
            s0 = gamC * s0 + bf_lo(inc); s1 = gamC * s1 + bf_hi(inc);
        }
    }
}

__device__ __forceinline__ void phase_retout(const Params& p, LAS unsigned char* lds, const int wv) {
    const int lane = lane_id(), wave = wv, tid = wv * 64 + lane;
    const bf16_t* qb = (const bf16_t*)(p.ws + WS_Q); const bf16_t* kb = (const bf16_t*)(p.ws + WS_K); const bf16_t* vb = (const bf16_t*)(p.ws + WS_V); const bf16_t* gb = (const bf16_t*)(p.ws + WS_G);
    const bf16_t* sprev = (const bf16_t*)(p.ws + WS_SPREV);
    bf16_t* R = (bf16_t*)((unsigned char*)p.out + DO_R);
    LAS unsigned char* Kt = lds; LAS unsigned char* Vt = Kt + 128 * RSK; LAS unsigned char* Sf = Vt + 128 * RSV; LAS unsigned char* Sb = Sf + 128 * RSK; LAS unsigned char* Pw = Sb + 128 * RSK + wave * (16 * RSV);
    u32x4 pk[2], pv[4], psf[2], psb[2];
#define RET_PREFETCH(itx) do { const int bh_ = (itx) >> 6, n_ = (itx) & 63, b_ = bh_ >> 3, h_ = bh_ & 7; const size_t tk_ = (size_t)b_ * SEQ + (size_t)n_ * CH; \
        stage_load<128, 64>(pk, kb + tk_ * 512 + h_ * 64, 512, tid); stage_load<128, 128>(pv, vb + tk_ * 1024 + h_ * 128, 1024, tid); \
        stage_load<128, 64>(psf, sprev + ((size_t)(itx) * 2 + 0) * 8192, 64, tid); stage_load<128, 64>(psb, sprev + ((size_t)(itx) * 2 + 1) * 8192, 64, tid); \
        } while (0)
    if ((int)blockIdx.x < 1024) RET_PREFETCH((int)blockIdx.x);
    for (int it = blockIdx.x; it < 1024; it += gridDim.x) {
        const int bh = it >> 6, n = it & 63, b = bh >> 3, h = bh & 7;
        const size_t tok0 = (size_t)b * SEQ + (size_t)n * CH;
        const float lgf = -__expf(p.dec_f[h]) * 1.4426950408889634f, lgb = -__expf(p.dec_b[h]) * 1.4426950408889634f;
        const int cl = 16 * wave + (lane & 15);
        const bf16_t* qr_ = qb + (tok0 + cl) * 512 + h * 64 + 8 * (lane >> 4);
        const bf16x8 q0 = *(const bf16x8*)qr_, q1 = *(const bf16x8*)(qr_ + 32);
        const size_t ro = (tok0 + cl) * 1024 + h * 128 + 4 * (lane >> 4);
        u32x2 ggv[8];
#pragma unroll
        for (int mt = 0; mt < 8; ++mt) ggv[mt] = *(const u32x2*)(gb + ro + 16 * mt);
        __syncthreads();
        stage_store<128, 64>(Kt, RSK, pk, tid); stage_store<128, 128>(Vt, RSV, pv, tid); stage_store<128, 64>(Sf, RSK, psf, tid); stage_store<128, 64>(Sb, RSK, psb, tid);
        __syncthreads();
        { const int itn = (it + (int)gridDim.x < 1024) ? it + (int)gridDim.x : it; RET_PREFETCH(itn); }
#pragma unroll
        for (int mt = 0; mt < 8; ++mt) {
            f32x4 sc = (f32x4){0.f, 0.f, 0.f, 0.f};
            sc = __builtin_amdgcn_mfma_f32_16x16x32_bf16(row_frag(Kt, RSK, 16 * mt, 0, lane), q0, sc, 0, 0, 0);
            sc = __builtin_amdgcn_mfma_f32_16x16x32_bf16(row_frag(Kt, RSK, 16 * mt, 32, lane), q1, sc, 0, 0, 0);
            float w[4];
#pragma unroll
            for (int r = 0; r < 4; ++r) { const int s = 16 * mt + 4 * (lane >> 4) + r, d = cl - s;
                w[r] = sc[r] * (d > 0 ? exp2f(lgf * (float)d) : (d < 0 ? exp2f(lgb * (float)(-d)) : 2.f)); }
            u32x2 o; o.x = cvt_pk_bf16(w[0], w[1]); o.y = cvt_pk_bf16(w[2], w[3]);
            *(LAS u32x2*)(Pw + (lane & 15) * RSV + (16 * mt + 4 * (lane >> 4)) * 2) = o;
        }
        asm volatile("s_waitcnt lgkmcnt(0)" ::: "memory");
        f32x4 o[8];
#pragma unroll
        for (int mt = 0; mt < 8; ++mt) o[mt] = (f32x4){0.f, 0.f, 0.f, 0.f};
#pragma unroll
        for (int ks = 0; ks < 4; ++ks) {
            const bf16x8 pf = *(const LAS bf16x8*)(Pw + (lane & 15) * RSV + (32 * ks + 8 * (lane >> 4)) * 2);
#pragma unroll
            for (int mt = 0; mt < 8; ++mt) o[mt] = __builtin_amdgcn_mfma_f32_16x16x32_bf16(tr_frag(Vt, RSV, 32 * ks, 16 * mt, lane), pf, o[mt], 0, 0, 0);
        }
        {
            const float sf = exp2f(lgf * (float)(cl + 1)), sb = exp2f(lgb * (float)(CH - cl));
            const bf16x8 qf0 = scale_frag(q0, sf), qf1 = scale_frag(q1, sf), qb0 = scale_frag(q0, sb), qb1 = scale_frag(q1, sb);
#pragma unroll
            for (int mt = 0; mt < 8; ++mt) {
                o[mt] = __builtin_amdgcn_mfma_f32_16x16x32_bf16(row_frag(Sf, RSK, 16 * mt, 0, lane), qf0, o[mt], 0, 0, 0);
                o[mt] = __builtin_amdgcn_mfma_f32_16x16x32_bf16(row_frag(Sf, RSK, 16 * mt, 32, lane), qf1, o[mt], 0, 0, 0);
                o[mt] = __builtin_amdgcn_mfma_f32_16x16x32_bf16(row_frag(Sb, RSK, 16 * mt, 0, lane), qb0, o[mt], 0, 0, 0);
                o[mt] = __builtin_amdgcn_mfma_f32_16x16x32_bf16(row_frag(Sb, RSK, 16 * mt, 32, lane), qb1, o[mt], 0, 0, 0);
            }
        }
        float s = 0.f;
#pragma unroll
        for (int mt = 0; mt < 8; ++mt) s += (o[mt][0] + o[mt][1]) + (o[mt][2] + o[mt][3]);
        s += __shfl_xor(s, 16); s += __shfl_xor(s, 32);
        const float mu = s * (1.f / DV);
        float s2 = 0.f;
#pragma unroll
        for (int mt = 0; mt < 8; ++mt) { o[mt] = o[mt] - mu; s2 += (o[mt][0] * o[mt][0] + o[mt][1] * o[mt][1]) + (o[mt][2] * o[mt][2] + o[mt][3] * o[mt][3]); }
        s2 += __shfl_xor(s2, 16); s2 += __shfl_xor(s2, 32);
        const float rstd = rsqrtf(s2 * (1.f / DV) + EPS);
#pragma unroll
        for (int mt = 0; mt < 8; ++mt) {
            const u32x2 gg = ggv[mt];
            u32x2 w; w.x = cvt_pk_bf16(o[mt][0] * rstd * siluf_(bf_lo(gg.x)), o[mt][1] * rstd * siluf_(bf_hi(gg.x)));
            w.y = cvt_pk_bf16(o[mt][2] * rstd * siluf_(bf_lo(gg.y)), o[mt][3] * rstd * siluf_(bf_hi(gg.y)));
            *(u32x2*)(R + ro + 16 * mt) = w;
        }
    }
}

constexpr int RSX = 528;
template <int STAGE> __device__ __forceinline__ void phase_dft(const Params& p, LAS unsigned char* lds, const int wv, const int it_lo, const int it_hi, const int it_step) {
    const int lane = lane_id(), wave = wv, tid = wv * 64 + lane;
    const float* T = (const float*)(p.ws + WS_T8192);
    const bf16_t* fbuf = (const bf16_t*)(p.ws + WS_F);
    bf16_t* Y = (bf16_t*)((unsigned char*)p.out + DO_Y);
    bf16_t* Z = (bf16_t*)(p.ws + WS_Z);
    LAS unsigned char* Mt = lds; LAS unsigned char* Xt = lds + 128 * RSV;
    for (int it = it_lo; it < it_hi; it += it_step) {
        const int b = it >> 7;
        const int l2 = it & 127;
        const int l1p = (it >> 1) & 63, chalf = it & 1;
        f32x4 acc[2][8];
#pragma unroll
        for (int hh = 0; hh < 2; ++hh) {
            __syncthreads();
            if (STAGE == 0 ? (hh == 0) : true) {
#pragma unroll 8
                for (int id = tid; id < 128 * 128; id += 512) {
                    const int o = id >> 7, k = id & 127; float val;
                    if constexpr (STAGE == 0) {
                        const int rip = o >> 6, l1q = o & 63, ri = k >> 6, l1 = k & 63;
                        const int j = (l1q * (128 * l1 + l2)) & 8191;
                        const float cs = T[j], sn = T[(j + 6144) & 8191];
                        val = (rip == ri) ? cs : (rip == 0 ? sn : -sn);
                    } else {
                        const int j = (64 * ((o * k) & 127)) & 8191;
                        val = hh == 0 ? T[j] : T[(j + 6144) & 8191];
                    }
                    *(LAS bf16_t*)(Mt + o * RSV + k * 2) = (bf16_t)(cvt_pk_bf16(val * 0.125f, 0.f) & 0xffffu);
                }
            }
            {
                u32x4 xv[8];
#pragma unroll
                for (int i = 0; i < 8; ++i) { const int id = tid + 512 * i, k = id >> 5, c = id & 31;
                    if constexpr (STAGE == 0) { const int ri = k >> 6, l1 = k & 63; xv[i] = *(const u32x4*)(fbuf + ((size_t)b * SEQ + 128 * l1 + l2) * 1024 + ri * 512 + hh * 256 + c * 8); }
                    else xv[i] = *(const u32x4*)(Y + ((((size_t)b * 64 + l1p) * 2 + hh) * 128 + k) * 512 + chalf * 256 + c * 8); }
#pragma unroll
                for (int i = 0; i < 8; ++i) { const int id = tid + 512 * i, k = id >> 5, c = id & 31; *(LAS u32x4*)(Xt + k * RSX + c * 16) = xv[i]; }
            }
            __syncthreads();
            if (STAGE == 0 || hh == 0) {
#pragma unroll
                for (int i = 0; i < 2; ++i)
#pragma unroll
                    for (int nt = 0; nt < 8; ++nt) acc[i][nt] = (f32x4){0.f, 0.f, 0.f, 0.f};
            }
#pragma unroll
            for (int ks = 0; ks < 4; ++ks) {
                const bf16x8 a0 = tr_frag(Xt, RSX, 32 * ks, 32 * wave, lane), a1 = tr_frag(Xt, RSX, 32 * ks, 32 * wave + 16, lane);
#pragma unroll
                for (int nt = 0; nt < 8; ++nt) { const bf16x8 bm = row_frag(Mt, RSV, 16 * nt, 32 * ks, lane);
                    acc[0][nt] = __builtin_amdgcn_mfma_f32_16x16x32_bf16(a0, bm, acc[0][nt], 0, 0, 0);
                    acc[1][nt] = __builtin_amdgcn_mfma_f32_16x16x32_bf16(a1, bm, acc[1][nt], 0, 0, 0); }
            }
            if (STAGE == 0 || hh == 1) {
#pragma unroll
                for (int i = 0; i < 2; ++i)
#pragma unroll
                    for (int nt = 0; nt < 8; ++nt) {
                        const int o = 16 * nt + (lane & 15), chl = 32 * wave + 16 * i + 4 * (lane >> 4);
                        u32x2 w; w.x = cvt_pk_bf16(acc[i][nt][0], acc[i][nt][1]); w.y = cvt_pk_bf16(acc[i][nt][2], acc[i][nt][3]);
                        if constexpr (STAGE == 0) { const int rip = o >> 6, l1q = o & 63;
                            *(u32x2*)(Y + ((((size_t)b * 64 + l1q) * 2 + rip) * 128 + l2) * 512 + hh * 256 + chl) = w;
                        } else *(u32x2*)(Z + ((size_t)b * SEQ + l1p + 64 * o) * 512 + chalf * 256 + chl) = w;
                    }
            }
        }
    }
}

#define XB_TMO      128
#define XB_XCNT(j)  (256  + 64 * (j))
#define XB_XSUB(j)  (1280 + 64 * (j))
#define XB_XGEN(j)  (2304 + 64 * (j))
#define XB_TOP      3328
#define XB_TOPGEN   3392
#define XCD_BAR_WORDS 3456
#define XB_SPIN_CAP (1u << 18)
__device__ __forceinline__ unsigned xb_ld(unsigned* p)              { return __hip_atomic_load(p, __ATOMIC_RELAXED, __HIP_MEMORY_SCOPE_AGENT); }
__device__ __forceinline__ unsigned xb_add(unsigned* p, unsigned v) { return __hip_atomic_fetch_add(p, v, __ATOMIC_RELAXED, __HIP_MEMORY_SCOPE_AGENT); }
__device__ __forceinline__ unsigned xb_xcc_id() { return (unsigned)__builtin_amdgcn_s_getreg((3 << 11) | 20) & 0xFu; }
#define XB_SPIN(cond, bar) do { unsigned _sp = 0; while (cond) { __builtin_amdgcn_s_sleep(1); \
    if ((++_sp & 255u) == 0u) { if (xb_ld(&(bar)[XB_TMO])) break; if (_sp > XB_SPIN_CAP) { atomicAdd(&(bar)[XB_TMO], 1u); break; } } } } while (0)
struct XcdBarrier { unsigned* bar; unsigned x; volatile LAS unsigned* st; };
__device__ __forceinline__ XcdBarrier xcd_barrier_post(unsigned* bar, volatile LAS unsigned* st, bool t0) {
    XcdBarrier b; b.bar = bar; b.x = xb_xcc_id(); b.st = st;
    if (t0) (void)xb_add(&bar[XB_XCNT(b.x)], 1u);
    return b;
}
__device__ __forceinline__ void xcd_barrier_complete(unsigned* bar, unsigned x, unsigned& nloc, unsigned& nx) {
    const unsigned G = gridDim.x * gridDim.y * gridDim.z;
    unsigned sum, cnt, mine, sp = 0u;
    for (;;) {
        sum = 0u; cnt = 0u; mine = 0u;
#pragma unroll
        for (unsigned j = 0; j < 16; ++j) { const unsigned c = xb_ld(&bar[XB_XCNT(j)]); sum += c; cnt += (c > 0u) ? 1u : 0u; mine = (j == x) ? c : mine; }
        if (sum == G) break;
        __builtin_amdgcn_s_sleep(1);
        if ((++sp & 255u) == 0u) { if (xb_ld(&bar[XB_TMO])) break; if (sp > XB_SPIN_CAP) { atomicAdd(&bar[XB_TMO], 1u); break; } }
    }
    nloc = mine > 0u ? mine : 1u; nx = cnt > 0u ? cnt : 1u;
}
__device__ __forceinline__ void xcd_barrier(const XcdBarrier& b, bool t0) {
    asm volatile("s_waitcnt vmcnt(0)" ::: "memory");
    __syncthreads();
    if (t0) {
        unsigned* bar = b.bar;
        __builtin_amdgcn_s_waitcnt(0);
        unsigned nloc = b.st[0], nx = b.st[1];
        if (nloc == 0u) { xcd_barrier_complete(bar, b.x, nloc, nx); b.st[0] = nloc; b.st[1] = nx; }
        const unsigned old = xb_add(&bar[XB_XSUB(b.x)], 1u);
        const unsigned gen = old / nloc;
        if (old + 1u == (gen + 1u) * nloc) {
            __builtin_amdgcn_fence(__ATOMIC_RELEASE, "agent");
            asm volatile("s_waitcnt vmcnt(0)" ::: "memory");
            const unsigned og = xb_add(&bar[XB_TOP], 1u);
            const unsigned tg = og / nx;
            if (og + 1u == (tg + 1u) * nx) xb_add(&bar[XB_TOPGEN], 1u);
            else XB_SPIN(xb_ld(&bar[XB_TOPGEN]) == tg, bar);
            __builtin_amdgcn_fence(__ATOMIC_ACQUIRE, "agent");
            xb_add(&bar[XB_XGEN(b.x)], 1u);
            asm volatile("s_waitcnt vmcnt(0)" ::: "memory");
        } else {
            XB_SPIN(xb_ld(&bar[XB_XGEN(b.x)]) == gen, bar);
            __builtin_amdgcn_fence(__ATOMIC_ACQUIRE, "agent");
            asm volatile("s_waitcnt vmcnt(0)" ::: "memory");
        }
    }
    __syncthreads();
}

__global__ void __launch_bounds__(512, 2) mk_fwd(Params p) {
    extern __shared__ __attribute__((aligned(16))) unsigned char shm[];
    LAS unsigned char* lds = (LAS unsigned char*)shm;
    unsigned char* ws = p.ws;
    const int wv = __builtin_amdgcn_readfirstlane((int)threadIdx.x >> 6);
    const int wave = wv;
    const int gw = blockIdx.x * 8 + wave, NGW = gridDim.x * 8;
    const float* modv = (const float*)(ws + WS_MODV);
    pg8::StaticOrder S;
#if MK_MULTI
#define GRID_SYNC() do { } while (0)
#else
    cg::grid_group grid = cg::this_grid();
#define GRID_SYNC() do { asm volatile("s_waitcnt vmcnt(0) lgkmcnt(0)" ::: "memory"); grid.sync(); \
        __builtin_amdgcn_fence(__ATOMIC_ACQUIRE, "agent"); asm volatile("s_waitcnt vmcnt(0)" ::: "memory"); } while (0)
#endif
#ifndef PH_MASK
#define PH_MASK 0xffff
#endif
#define IN(k) (((PH_MASK >> (k)) & 1) && p.ph_lo <= (k) && (k) < p.ph_hi)
#if MK_MULTI
#define SEAM(k) do { } while (0)
#else
    const bool t0 = (wv == 0) && (lane_id() == 0);
    volatile LAS unsigned* xst = (volatile LAS unsigned*)(lds + 131072 + 512);
    if (t0) { xst[0] = 0u; xst[1] = 0u; }
    __syncthreads();
    const XcdBarrier XB = xcd_barrier_post((unsigned*)(ws + WS_XBAR), xst, t0);
#define SEAM(k) do { if (IN(k) && IN((k) + 1)) xcd_barrier(XB, t0); } while (0)
#endif

#if !MK_MULTI
    if (p.ph_hi < 0) GRID_SYNC();
#endif
    if (IN(0)) phase_prep(p, lds, wv);
    SEAM(0);
    if (IN(1)) {
        bf16_t* hb = (bf16_t*)(ws + WS_H);
        const int ln = lane_id();
        for (int r = gw; r < M + MC; r += 2 * NGW) {
            const int r1 = r + NGW; const bool v1 = r1 < M + MC; const int q1 = v1 ? r1 : r;
            const int i0 = r < M ? (r >> 13) : 2, i1 = q1 < M ? (q1 >> 13) : 2;
            const float* x0 = r < M ? p.x + (size_t)r * D : p.ctx + (size_t)(r - M) * D; const float* x1p = q1 < M ? p.x + (size_t)q1 * D : p.ctx + (size_t)(q1 - M) * D;
            norm_row2<0>(x0, x1p, p.norm1_w, modv + i0 * 6144 + 1024, modv + i0 * 6144, modv + i1 * 6144 + 1024, modv + i1 * 6144, hb + (size_t)r * D, hb + (size_t)q1 * D, v1, ln);
        }
    }
    SEAM(1);
    if (IN(2)) {
        EpiInProj E; E.q = (bf16_t*)(ws + WS_Q); E.k = (bf16_t*)(ws + WS_K); E.v = (bf16_t*)(ws + WS_V); E.g = (bf16_t*)(ws + WS_G); E.f = (bf16_t*)(ws + WS_F);
        E.ropec = (const float*)(ws + WS_ROPEC); E.ropes = (const float*)(ws + WS_ROPES);
        pg8::Gemm g{(const bf16_t*)(ws + WS_H), (const bf16_t*)(ws + WS_WIN), M / 256, NIN / 256, D};
        S.init(g.nM, g.nN, gridDim.x, blockIdx.x);
        pg8::gemm_phase<EpiInProj>(lds, g, S, E, wv);
    }
    SEAM(2);
    if (IN(3)) {
#if MK_MULTI
        {
            EpiBf16 E; E.O = (bf16_t*)(ws + WS_KVC); E.ldc = 1536;
            pg8::Gemm g{(const bf16_t*)(ws + WS_H) + (size_t)M * D, (const bf16_t*)(ws + WS_WIN) + (size_t)512 * D, MC / 256, 1536 / 256, D};
            S.init(g.nM, g.nN, gridDim.x, (int)gridDim.x - 1 - (int)blockIdx.x);
            pg8::gemm_phase<EpiBf16>(lds, g, S, E, wv);
        }
        phase_kvinc(p, lds, wv, (int)blockIdx.x, 1024, (int)gridDim.x);
        phase_dft<0>(p, lds, wv, (int)blockIdx.x, 256, (int)gridDim.x);
#else
        {
            EpiBf16 E; E.O = (bf16_t*)(ws + WS_KVC); E.ldc = 1536;
            pg8::Gemm g{(const bf16_t*)(ws + WS_H) + (size_t)M * D, (const bf16_t*)(ws + WS_WIN) + (size_t)512 * D, MC / 256, 1536 / 256, D};
            S.init(g.nM, g.nN, gridDim.x, (int)gridDim.x - 1 - (int)blockIdx.x);
            pg8::gemm_phase<EpiBf16>(lds, g, S, E, wv);
        }
        unsigned* qctr = (unsigned*)(ws + WS_XBAR) + 3600;
        volatile LAS unsigned* qslot = (volatile LAS unsigned*)(lds + 131072 + 640);
        for (;;) {
            __syncthreads();
            if (t0) qslot[0] = __hip_atomic_fetch_add(qctr, 1u, __ATOMIC_RELAXED, __HIP_MEMORY_SCOPE_AGENT);
            __syncthreads();
            const int id = __builtin_amdgcn_readfirstlane((int)qslot[0]);
            if (id >= 256 + 1024) break;
            if (id < 256) phase_dft<0>(p, lds, wv, id, id + 1, 1);
            else phase_kvinc(p, lds, wv, id - 256, id - 255, 1);
        }
#endif
    }
    SEAM(3);
    if (IN(4)) { phase_scan(p, wv); phase_dft<1>(p, lds, wv, (int)blockIdx.x, 256, (int)gridDim.x); }
    SEAM(4);
    if (IN(5)) phase_retout(p, lds, wv);
    SEAM(5);
    if (IN(6)) {
        {
            EpiBf16 E; E.O = (bf16_t*)(ws + WS_RETD); E.ldc = D;
            pg8::Gemm g{(const bf16_t*)((unsigned char*)p.out + DO_R), (const bf16_t*)(ws + WS_WRO), M / 256, D / 256, D};
            S.init(g.nM, g.nN, gridDim.x, blockIdx.x);
            pg8::gemm_phase<EpiBf16>(lds, g, S, E, wv);
        }
        {
            EpiBf16 E; E.O = (bf16_t*)(ws + WS_FOURD); E.ldc = D;
            pg8::Gemm g{(const bf16_t*)(ws + WS_Z), (const bf16_t*)(ws + WS_WFO), M / 256, D / 256, 512};
            S.init(g.nM, g.nN, gridDim.x, blockIdx.x);
            pg8::gemm_phase<EpiBf16>(lds, g, S, E, wv);
        }
    }
    SEAM(6);
    if (IN(7)) {
        EpiMerge E; E.retd = (const bf16_t*)(ws + WS_RETD); E.fourd = (const bf16_t*)(ws + WS_FOURD); E.bbg = p.b_bg; E.merged = (bf16_t*)(ws + WS_MERGED);
        pg8::Gemm g{(const bf16_t*)(ws + WS_H), (const bf16_t*)(ws + WS_WBG), M / 256, 2048 / 256, D};
        S.init(g.nM, g.nN, gridDim.x, blockIdx.x);
        pg8::gemm_phase<EpiMerge>(lds, g, S, E, wv);
    }
    SEAM(7);
    if (IN(8)) {
        EpiResidT<false, true> E; E.xin = (const void*)p.x; E.gate = modv + 2048; E.out = (void*)(ws + WS_X1);
        pg8::Gemm g{(const bf16_t*)(ws + WS_MERGED), (const bf16_t*)(ws + WS_WOUT), M / 256, D / 256, D};
        S.init(g.nM, g.nN, gridDim.x, blockIdx.x);
        pg8::gemm_phase<EpiResidT<false, true>>(lds, g, S, E, wv);
    }
    SEAM(8);
    if (IN(9)) {
        bf16_t* hb = (bf16_t*)(ws + WS_H); const bf16_t* x1 = (const bf16_t*)(ws + WS_X1);
        const int ln = lane_id();
        for (int r = gw; r < M; r += 2 * NGW) {
            const int r1 = r + NGW; const bool v1 = r1 < M; const int q1 = v1 ? r1 : r; const int b0 = r >> 13, b1 = q1 >> 13;
            u32x2 a[4], c[4]; f32x4 fa[4], fc[4]; float s0 = 0.f, s1 = 0.f;
#pragma unroll
            for (int j = 0; j < 4; ++j) { a[j] = *(const u32x2*)(x1 + (size_t)r * D + 4 * ln + 256 * j); c[j] = *(const u32x2*)(x1 + (size_t)q1 * D + 4 * ln + 256 * j); }
#pragma unroll
            for (int j = 0; j < 4; ++j) {
                fa[j] = (f32x4){bf_lo(a[j].x), bf_hi(a[j].x), bf_lo(a[j].y), bf_hi(a[j].y)}; fc[j] = (f32x4){bf_lo(c[j].x), bf_hi(c[j].x), bf_lo(c[j].y), bf_hi(c[j].y)};
                s0 += (fa[j][0] * fa[j][0] + fa[j][1] * fa[j][1]) + (fa[j][2] * fa[j][2] + fa[j][3] * fa[j][3]);
                s1 += (fc[j][0] * fc[j][0] + fc[j][1] * fc[j][1]) + (fc[j][2] * fc[j][2] + fc[j][3] * fc[j][3]);
            }
#pragma unroll
            for (int o = 1; o < 64; o <<= 1) { s0 += __shfl_xor(s0, o); s1 += __shfl_xor(s1, o); }
            const float rs0 = rsqrtf(s0 * (1.f / D) + EPS), rs1 = rsqrtf(s1 * (1.f / D) + EPS);
#pragma unroll
            for (int j = 0; j < 4; ++j) {
                const int cidx = 4 * ln + 256 * j; const f32x4 wv_ = *(const f32x4*)(p.norm2_w + cidx);
                const f32x4 y0 = fa[j] * rs0 * wv_ * (*(const f32x4*)(modv + b0 * 6144 + 4096 + cidx) + 1.f) + *(const f32x4*)(modv + b0 * 6144 + 3072 + cidx);
                const f32x4 y1 = fc[j] * rs1 * wv_ * (*(const f32x4*)(modv + b1 * 6144 + 4096 + cidx) + 1.f) + *(const f32x4*)(modv + b1 * 6144 + 3072 + cidx);
                u32x2 w0; w0.x = cvt_pk_bf16(y0[0], y0[1]); w0.y = cvt_pk_bf16(y0[2], y0[3]); *(u32x2*)(hb + (size_t)r * D + cidx) = w0;
                if (v1) { u32x2 w1; w1.x = cvt_pk_bf16(y1[0], y1[1]); w1.y = cvt_pk_bf16(y1[2], y1[3]); *(u32x2*)(hb + (size_t)q1 * D + cidx) = w1; }
            }
        }
    }
    SEAM(9);
    if (IN(10)) {
        EpiUpConv E; E.convw = p.conv_w; E.convb = p.conv_b; E.act = (bf16_t*)(ws + WS_ACT); E.wl = (LAS float*)(lds + 131072 + 1024);
        pg8::Gemm g{(const bf16_t*)(ws + WS_H), (const bf16_t*)(ws + WS_WUP), CONV_NM, NUP / 256, D};
        S.init(g.nM, g.nN, gridDim.x, blockIdx.x);
        pg8::gemm_phase<EpiUpConv, true>(lds, g, S, E, wv);
    }
    SEAM(10);
    if (IN(11)) {
        EpiResidT<true, true> E; E.xin = (const void*)(ws + WS_X1); E.gate = modv + 5120; E.out = (void*)(ws + WS_X2B);
        pg8::Gemm g{(const bf16_t*)(ws + WS_ACT), (const bf16_t*)(ws + WS_WDN), M / 256, D / 256, FFN};
        S.init(g.nM, g.nN, gridDim.x, blockIdx.x);
        pg8::gemm_phase<EpiResidT<true, true>>(lds, g, S, E, wv);
    }
    SEAM(11);
    if (IN(12)) {
        const int ln = lane_id(); const bf16_t* x2 = (const bf16_t*)(ws + WS_X2B);
        for (int r = gw; r < M; r += 2 * NGW) {
            const int r1 = r + NGW; const bool v1 = r1 < M; const int q1 = v1 ? r1 : r;
            u32x2 a[4], c[4]; f32x4 fa[4], fc[4]; float s0 = 0.f, s1 = 0.f;
#pragma unroll
            for (int j = 0; j < 4; ++j) { a[j] = *(const u32x2*)(x2 + (size_t)r * D + 4 * ln + 256 * j); c[j] = *(const u32x2*)(x2 + (size_t)q1 * D + 4 * ln + 256 * j); }
#pragma unroll
            for (int j = 0; j < 4; ++j) {
                fa[j] = (f32x4){bf_lo(a[j].x), bf_hi(a[j].x), bf_lo(a[j].y), bf_hi(a[j].y)}; fc[j] = (f32x4){bf_lo(c[j].x), bf_hi(c[j].x), bf_lo(c[j].y), bf_hi(c[j].y)};
                s0 += (fa[j][0] * fa[j][0] + fa[j][1] * fa[j][1]) + (fa[j][2] * fa[j][2] + fa[j][3] * fa[j][3]);
                s1 += (fc[j][0] * fc[j][0] + fc[j][1] * fc[j][1]) + (fc[j][2] * fc[j][2] + fc[j][3] * fc[j][3]);
            }
#pragma unroll
            for (int o = 1; o < 64; o <<= 1) { s0 += __shfl_xor(s0, o); s1 += __shfl_xor(s1, o); }
            const float rs0 = rsqrtf(s0 * (1.f / D) + EPS), rs1 = rsqrtf(s1 * (1.f / D) + EPS);
#pragma unroll
            for (int j = 0; j < 4; ++j) {
                const int cidx = 4 * ln + 256 * j; const f32x4 wv_ = *(const f32x4*)(p.fnorm_w + cidx);
                *(f32x4*)(p.out + (size_t)r * D + cidx) = fa[j] * rs0 * wv_;
                if (v1) *(f32x4*)(p.out + (size_t)q1 * D + cidx) = fc[j] * rs1 * wv_;
            }
        }
    }
}

constexpr int N_PHASES = 13;

extern "C" void kernel_launch(void* const* d_in, const int* in_sizes, int n_in, void* d_out, int out_size, void* d_ws, size_t ws_size, hipStream_t stream) {
    static int grid = 0;
    if (grid == 0) {
        int dev = 0, cus = 0, per_cu = 0;
        if (hipGetDevice(&dev) != hipSuccess || hipDeviceGetAttribute(&cus, hipDeviceAttributeMultiprocessorCount, dev) != hipSuccess) { fprintf(stderr, "kernel_launch: device query failed\n"); grid = -1; return; }
        if (hipFuncSetAttribute((const void*)mk_fwd, hipFuncAttributeMaxDynamicSharedMemorySize, LDS_BYTES) != hipSuccess) { fprintf(stderr, "kernel_launch: hipFuncSetAttribute failed\n"); grid = -1; return; }
        if (hipOccupancyMaxActiveBlocksPerMultiprocessor(&per_cu, (const void*)mk_fwd, 512, LDS_BYTES) != hipSuccess || per_cu < 1) { fprintf(stderr, "kernel_launch: occupancy query says %d\n", per_cu); per_cu = 1; }
        (void)hipGetLastError();
        grid = cus * 1;
        if (ws_size < 256 * MiB) { fprintf(stderr, "kernel_launch: workspace too small (%zu)\n", ws_size); grid = -1; return; }
    }
    if (grid < 0) return;
    Params p{};
    p.x = (const float*)d_in[0]; p.c = (const float*)d_in[1]; p.ctx = (const float*)d_in[2]; p.c_ctx = (const float*)d_in[3]; p.w_mod = (const float*)d_in[4]; p.b_mod = (const float*)d_in[5];
    p.norm1_w = (const float*)d_in[6]; p.w_in = (const float*)d_in[7]; p.dec_f = (const float*)d_in[8]; p.dec_b = (const float*)d_in[9]; p.w_ro = (const float*)d_in[10]; p.w_fo = (const float*)d_in[11];
    p.w_bg = (const float*)d_in[12]; p.b_bg = (const float*)d_in[13]; p.w_out = (const float*)d_in[14]; p.norm2_w = (const float*)d_in[15]; p.w_up = (const float*)d_in[16]; p.conv_w = (const float*)d_in[17];
    p.conv_b = (const float*)d_in[18]; p.w_down = (const float*)d_in[19]; p.fnorm_w = (const float*)d_in[20];
    p.out = (float*)d_out; p.ws = (unsigned char*)d_ws;
#if MK_MULTI
    for (int ph = 0; ph < N_PHASES; ++ph) {
        p.ph_lo = ph; p.ph_hi = ph + 1;
        hipLaunchKernelGGL(mk_fwd, dim3(grid), dim3(512), LDS_BYTES, stream, p);
#ifdef DBG_CHECK
        int* fl = (int*)((unsigned char*)d_ws + 3 * MiB);
        if (ph == 0) { hipMemsetAsync(fl, 0x3f, 4, stream); hipMemsetAsync(fl + 1, 0, 4, stream); hipMemsetAsync(fl + 32, 0, 1024, stream); }
#define VER(id) hipLaunchKernelGGL(dbg_verify, dim3(64), dim3(128), 0, stream, p, id, fl)
        if (ph == 0) VER(1);
        if (ph == 1) VER(2);
        if (ph == 2) { VER(3); VER(4); VER(5); }
        if (ph == 3) { VER(6); VER(7); }
        if (ph == 4) { VER(8); VER(9); }
        if (ph == 5) VER(10);
        if (ph == 6) VER(11);
        if (ph == 7) VER(12);
        if (ph == 8) VER(13);
        if (ph == 9) VER(14);
        if (ph == 10) VER(15);
        if (ph == 11) { VER(16); VER(17); }
        if (ph == 12) hipLaunchKernelGGL(dbg_fin, dim3(16384), dim3(256), 0, stream, (float*)d_out, (const int*)fl);
#endif
    }
#else
#if defined(REP_LO)
    const int los[2] = {0, REP_LO}, his[2] = {REP_HI, N_PHASES};
    for (int li = 0; li < 2; ++li) {
        p.ph_lo = los[li]; p.ph_hi = his[li];
        (void)hipMemsetAsync((unsigned char*)d_ws + WS_XBAR, 0, 16384, stream);
        void* args[] = {&p};
        hipError_t e = hipLaunchCooperativeKernel((const void*)mk_fwd, dim3(grid), dim3(512), args, LDS_BYTES, stream);
        if (e != hipSuccess) fprintf(stderr, "kernel_launch: cooperative launch failed: %s (grid %d)\n", hipGetErrorString(e), grid);
    }
#else
    (void)hipMemsetAsync((unsigned char*)d_ws + WS_XBAR, 0, 16384, stream);
    p.ph_lo = 0; p.ph_hi = N_PHASES;
    void* args[] = {&p};
    hipError_t e = hipLaunchCooperativeKernel((const void*)mk_fwd, dim3(grid), dim3(512), args, LDS_BYTES, stream);
    if (e != hipSuccess) fprintf(stderr, "kernel_launch: cooperative launch failed: %s (grid %d)\n", hipGetErrorString(e), grid);
#endif
#endif
}
```

```cpp
#include <hip/hip_runtime.h>
#include <hip/hip_cooperative_groups.h>
#include <cstdio>
#include <cstdint>
namespace cg = cooperative_groups;

#ifndef MK_MULTI
#define MK_MULTI 0
#endif

#define LAS __attribute__((address_space(3)))
typedef unsigned short bf16_t;
typedef short bf16x8 __attribute__((ext_vector_type(8)));
typedef short s16x4 __attribute__((ext_vector_type(4)));
typedef float f32x4 __attribute__((ext_vector_type(4)));
typedef float f32x2 __attribute__((ext_vector_type(2)));
typedef unsigned u32x4 __attribute__((ext_vector_type(4)));
typedef unsigned u32x2 __attribute__((ext_vector_type(2)));

constexpr int D = 1024, NB = 2, SEQ = 8192, M = NB * SEQ, CTX = 256, MC = NB * CTX;
constexpr int NH = 8, DK = 64, DV = 128, CH = 128, NCH = SEQ / CH;
constexpr int INC = 3584, FFN = 2816, NUP = 2 * FFN;
constexpr int NIN = 4096;
constexpr float EPS = 1e-6f;
constexpr int CONV_UNITS_PER_BATCH = 34, CONV_NM = 2 * CONV_UNITS_PER_BATCH;

constexpr size_t MiB = 1u << 20;
constexpr size_t WS_MODV = 0;
constexpr size_t WS_ROPEC = 128 * 1024;
constexpr size_t WS_ROPES = 160 * 1024;
constexpr size_t WS_T8192 = 192 * 1024;
constexpr size_t WS_XBAR = 3 * MiB + 65536;
constexpr size_t WS_KVC = 1 * MiB;
constexpr size_t WS_WIN = 4 * MiB;
constexpr size_t WS_WRO = 12 * MiB;
constexpr size_t WS_WFO = 14 * MiB;
constexpr size_t WS_WBG = 15 * MiB;
constexpr size_t WS_WOUT = 19 * MiB;
constexpr size_t WS_WUP = 21 * MiB;
constexpr size_t WS_WDN = 32 * MiB;
constexpr size_t WS_H = 38 * MiB;
constexpr size_t WS_Q = 72 * MiB;
constexpr size_t WS_K = 88 * MiB;
constexpr size_t WS_V = 104 * MiB;
constexpr size_t WS_G = 136 * MiB;
constexpr size_t WS_F = 168 * MiB;
constexpr size_t WS_Z = 200 * MiB;
constexpr size_t WS_X1 = 72 * MiB;
constexpr size_t WS_RETD = 72 * MiB;
constexpr size_t WS_FOURD = 104 * MiB;
constexpr size_t WS_MERGED = 136 * MiB;
constexpr size_t WS_SPREV = 216 * MiB;
constexpr size_t WS_X2B = 224 * MiB;
constexpr size_t WS_ACT = 136 * MiB;
constexpr size_t DO_KVINC = 0;
constexpr size_t DO_Y = 32 * MiB;
constexpr size_t DO_R = 0;

constexpr int LDS_BYTES = 147456;

typedef __bf16 bf16x2_t __attribute__((ext_vector_type(2)));
__device__ __forceinline__ unsigned cvt_pk_bf16(float lo, float hi) { const f32x2 v = {lo, hi}; const bf16x2_t b = __builtin_convertvector(v, bf16x2_t); return __builtin_bit_cast(unsigned, b); }
__device__ __forceinline__ float bf_lo(unsigned u) { return __uint_as_float(u << 16); }
__device__ __forceinline__ float bf_hi(unsigned u) { return __uint_as_float(u & 0xffff0000u); }
__device__ __forceinline__ float bf2f(bf16_t b) { return __uint_as_float(((unsigned)b) << 16); }
__device__ __forceinline__ float sigmoidf_(float x) { return 1.f / (1.f + __expf(-x)); }
__device__ __forceinline__ float siluf_(float x) { return x / (1.f + __expf(-x)); }
__device__ __forceinline__ float gelu_tanh(float a) { const float u = 0.7978845608028654f * (a + 0.044715f * a * a * a); return a / (1.f + __expf(-2.f * u)); }
template <class T> __device__ __forceinline__ T* at_off(const void* base, unsigned byte_off) { return (T*)((char*)base + byte_off); }
__device__ __forceinline__ int lane_id() { int r; asm volatile("v_mbcnt_lo_u32_b32 %0, -1, 0\n\tv_mbcnt_hi_u32_b32 %0, -1, %0" : "=v"(r)); return r; }
__device__ __forceinline__ float wave_sum(float v) {
#pragma unroll
    for (int o = 1; o < 64; o <<= 1) v += __shfl_xor(v, o);
    return v;
}

namespace pg8 {
constexpr int BM = 256, BK = 64, HALF = 128, HTB = HALF * BK * 2, STAGE_BYTES = 8 * HTB, NXCD = 8, WGM = 8;
__host__ __device__ __forceinline__ int lds_byte(int r, int c) { const int st = (r >> 4) * 2 + (c >> 5), rr = r & 15, cc = c & 31, ob = rr * 64 + cc * 2; return st * 1024 + (ob ^ (((ob >> 9) & 1) << 5)); }
__host__ __device__ __forceinline__ void stage_rc(int b, int& R, int& C) { const int st = b / 1024, sb = b % 1024, swz = sb ^ (((sb >> 9) & 1) << 5); R = (st >> 1) * 16 + swz / 64; C = (st & 1) * 32 + (swz % 64) / 2; }
__host__ __device__ __forceinline__ int perm32(int rho) { const int n = rho >> 4, i = rho & 15; return 8 * (i >> 2) + 4 * n + (i & 3); }

struct Unit { int pm, pn; };
struct Gemm { const bf16_t* A; const bf16_t* Bt; int nM, nN, K; };

struct StaticOrder {
    int nM, nN, nwg, G, c;
    __device__ void init(int nM_, int nN_, int G_, int c_) { nM = nM_; nN = nN_; nwg = nM * nN; G = G_; c = c_; }
    __device__ bool next(int i, Unit& u) const {
        const long L = (long)i * G + c; if (L >= nwg) return false;
        int wgid = (int)L; { const int q = nwg / NXCD, r = nwg % NXCD, xcd = wgid % NXCD, off = wgid / NXCD; wgid = (xcd < r ? xcd * (q + 1) : r * (q + 1) + (xcd - r) * q) + off; }
        const int nig = WGM * nN, gid = wgid / nig, fm = gid * WGM, gsz = (nM - fm) < WGM ? (nM - fm) : WGM;
        u.pm = fm + ((wgid % nig) % gsz); u.pn = (wgid % nig) / gsz; return true;
    }
};

template <bool CONVA> __device__ __forceinline__ const char* a_panel(const Gemm& g, int pm) {
    if constexpr (CONVA) { const int b = pm / CONV_UNITS_PER_BATCH, u = pm % CONV_UNITS_PER_BATCH; return (const char*)g.A + ((long)b * SEQ + 248L * u - 1L) * (long)g.K * 2L; }
    else return (const char*)g.A + (size_t)pm * (size_t)(BM * 2) * g.K;
}

template <class Epi, bool CONVA = false, bool ALIGN_EPI = true, bool SP2 = true>
__device__ __forceinline__ void gemm_phase(LAS unsigned char* lds, const Gemm g, const StaticOrder& S, const Epi& E, const int wv) {
    const int lane = lane_id(), tid = wv * 64 + lane, wid = wv, wr = wid >> 2, wc = wid & 3, fr = lane & 15, fq = lane >> 4;
    const int K = g.K, nt = K / BK;
    unsigned voffA[2], voffB[2];
#pragma unroll
    for (int i = 0; i < 2; ++i) { int R, C; stage_rc(tid * 16 + i * 8192, R, C); const int Rb = Epi::PERM ? ((R & ~31) + perm32(R & 31)) : R;
        const int Ra = CONVA ? ((R >> 6) * 62 + (R & 63)) : R;
        voffA[i] = (unsigned)(Ra * K + C) * 2u; voffB[i] = (unsigned)(Rb * K + C) * 2u; }
    const size_t kstep = (size_t)(BK * 2);
    const size_t hstep = (size_t)HALF * K * 2;
    const size_t hstepA = CONVA ? (size_t)124 * K * 2 : hstep;
    const size_t tstep = 2 * hstep;
    const unsigned ldsw = (unsigned)wid * 1024u;
    const int aoff = lds_byte(wr * 64 + fr, fq * 8), boff = lds_byte(wc * 32 + fr, fq * 8);
#define PG8_SA(b, h) (((b) * 2 + (h)) * HTB)
#define PG8_SB(b, h) ((4 + (b) * 2 + (h)) * HTB)
#define PG8_STAGE(bufoff, gbase, voff) do { _Pragma("unroll") for (int _i = 0; _i < 2; ++_i) \
        __builtin_amdgcn_global_load_lds((const unsigned*)((const char*)(gbase) + (voff)[_i]), (LAS unsigned*)(lds + (bufoff) + ldsw + _i * 8192), 16, 0, 0); } while (0)
#define PG8_LDA(dst, b, h) do { _Pragma("unroll") for (int m = 0; m < 4; ++m) _Pragma("unroll") for (int k = 0; k < 2; ++k) dst[m][k] = *(const LAS bf16x8*)(lds + PG8_SA(b, h) + aoff + m * 2048 + k * 1024); } while (0)
#define PG8_LDB(dst, b, h) do { _Pragma("unroll") for (int n = 0; n < 2; ++n) _Pragma("unroll") for (int k = 0; k < 2; ++k) dst[n][k] = *(const LAS bf16x8*)(lds + PG8_SB(b, h) + boff + n * 2048 + k * 1024); } while (0)
#define PG8_MMA(ai, bj, At, Bt) do { __builtin_amdgcn_s_setprio(1); _Pragma("unroll") for (int m = 0; m < 4; ++m) _Pragma("unroll") for (int n = 0; n < 2; ++n) _Pragma("unroll") for (int k = 0; k < 2; ++k) \
        acc[ai][bj][m][n] = __builtin_amdgcn_mfma_f32_16x16x32_bf16(Bt[n][k], At[m][k], acc[ai][bj][m][n], 0, 0, 0); __builtin_amdgcn_s_setprio(0); } while (0)
#define PG8_WAIT_V(n) asm volatile("s_waitcnt vmcnt(" #n ")" ::: "memory")
#define PG8_WAIT_L(n) asm volatile("s_waitcnt lgkmcnt(" #n ")" ::: "memory")
#define PG8_BAR __builtin_amdgcn_s_barrier()
#define PG8_SCHED __builtin_amdgcn_sched_barrier(0)
    Unit cur, nxt; int ui = 0;
    if (!S.next(0, cur)) return;
    f32x4 acc[2][2][4][2];
#pragma unroll
    for (int a = 0; a < 2; ++a)
#pragma unroll
        for (int b = 0; b < 2; ++b)
#pragma unroll
            for (int m = 0; m < 4; ++m)
#pragma unroll
                for (int n = 0; n < 2; ++n) acc[a][b][m][n] = (f32x4){0.f, 0.f, 0.f, 0.f};
    bf16x8 At[4][2], B0[2][2], B1[2][2];
    const char* cA = a_panel<CONVA>(g, cur.pm); const char* cB = (const char*)g.Bt + (size_t)cur.pn * tstep;
    if constexpr (SP2) {
        PG8_STAGE(PG8_SB(0, 0), cB, voffB); PG8_STAGE(PG8_SB(0, 1), cB + hstep, voffB); PG8_STAGE(PG8_SA(0, 0), cA, voffA); PG8_STAGE(PG8_SA(0, 1), cA + hstepA, voffA);
        if (wr == 1) PG8_BAR;
        PG8_WAIT_V(2); PG8_BAR;
        PG8_STAGE(PG8_SB(1, 0), cB + kstep, voffB); PG8_STAGE(PG8_SA(1, 0), cA + kstep, voffA); PG8_STAGE(PG8_SB(1, 1), cB + hstep + kstep, voffB);
        PG8_WAIT_V(6); PG8_BAR;
    } else {
        PG8_STAGE(PG8_SB(0, 0), cB, voffB); PG8_STAGE(PG8_SA(0, 0), cA, voffA); PG8_STAGE(PG8_SB(0, 1), cB + hstep, voffB); PG8_STAGE(PG8_SA(0, 1), cA + hstepA, voffA);
        if (wr == 1) PG8_BAR;
        PG8_WAIT_V(4); PG8_BAR;
        PG8_STAGE(PG8_SB(1, 0), cB + kstep, voffB); PG8_STAGE(PG8_SA(1, 0), cA + kstep, voffA); PG8_STAGE(PG8_SB(1, 1), cB + hstep + kstep, voffB);
        PG8_WAIT_V(6); PG8_BAR;
    }
    for (;;) {
        const bool has_next = S.next(ui + 1, nxt);
        const char* nA = has_next ? a_panel<CONVA>(g, nxt.pm) : cA; const char* nB = has_next ? (const char*)g.Bt + (size_t)nxt.pn * tstep : cB;
        for (int t = 0; t < nt; t += 2) {
            const bool last = (t == nt - 2);
            const char* a1 = cA + (size_t)(t + 1) * kstep;
            const char* a2 = last ? nA : cA + (size_t)(t + 2) * kstep; const char* b2 = last ? nB : cB + (size_t)(t + 2) * kstep;
            const char* a3 = a2 + kstep; const char* b3 = b2 + kstep;
            if constexpr (SP2) {
            PG8_LDB(B0, 0, 0); PG8_LDB(B1, 0, 1); PG8_SCHED; PG8_LDA(At, 0, 0); PG8_STAGE(PG8_SA(1, 1), a1 + hstepA, voffA);
            PG8_WAIT_V(8); PG8_WAIT_L(0); PG8_BAR; PG8_MMA(0, 0, At, B0); PG8_MMA(0, 1, At, B1); PG8_BAR; PG8_SCHED;
            PG8_LDA(At, 0, 1); PG8_STAGE(PG8_SB(0, 0), b2, voffB); PG8_STAGE(PG8_SB(0, 1), b2 + hstep, voffB); PG8_STAGE(PG8_SA(0, 0), a2, voffA);
            PG8_WAIT_V(8); PG8_WAIT_L(0); PG8_BAR; PG8_MMA(1, 0, At, B0); PG8_MMA(1, 1, At, B1); PG8_BAR; PG8_SCHED;
            PG8_LDB(B0, 1, 0); PG8_LDB(B1, 1, 1); PG8_SCHED; PG8_LDA(At, 1, 0); PG8_STAGE(PG8_SA(0, 1), a2 + hstepA, voffA);
            PG8_WAIT_V(8); PG8_WAIT_L(0); PG8_BAR; PG8_MMA(0, 0, At, B0); PG8_MMA(0, 1, At, B1); PG8_BAR; PG8_SCHED;
            PG8_LDA(At, 1, 1); PG8_STAGE(PG8_SB(1, 0), b3, voffB); PG8_STAGE(PG8_SB(1, 1), b3 + hstep, voffB); PG8_STAGE(PG8_SA(1, 0), a3, voffA);
            PG8_WAIT_V(8); PG8_WAIT_L(0); PG8_BAR; PG8_MMA(1, 0, At, B0); PG8_MMA(1, 1, At, B1); PG8_BAR; PG8_SCHED;
            } else {
            PG8_LDB(B0, 0, 0); PG8_SCHED; PG8_LDA(At, 0, 0); PG8_STAGE(PG8_SA(1, 1), a1 + hstepA, voffA);
            PG8_WAIT_L(8); PG8_BAR; PG8_WAIT_L(0); PG8_MMA(0, 0, At, B0); PG8_BAR; PG8_SCHED;
            PG8_LDB(B1, 0, 1); PG8_STAGE(PG8_SB(0, 0), b2, voffB);
            PG8_BAR; PG8_WAIT_L(0); PG8_MMA(0, 1, At, B1); PG8_BAR;
            PG8_LDA(At, 0, 1); PG8_STAGE(PG8_SA(0, 0), a2, voffA);
            PG8_BAR; PG8_WAIT_L(0); PG8_MMA(1, 0, At, B0); PG8_BAR; PG8_SCHED;
            PG8_STAGE(PG8_SB(0, 1), b2 + hstep, voffB);
            PG8_WAIT_V(6); PG8_BAR; PG8_MMA(1, 1, At, B1); PG8_BAR;
            PG8_LDB(B0, 1, 0); PG8_SCHED; PG8_LDA(At, 1, 0); PG8_STAGE(PG8_SA(0, 1), a2 + hstepA, voffA);
            PG8_WAIT_L(8); PG8_BAR; PG8_WAIT_L(0); PG8_MMA(0, 0, At, B0); PG8_BAR; PG8_SCHED;
            PG8_LDB(B1, 1, 1); PG8_STAGE(PG8_SB(1, 0), b3, voffB);
            PG8_BAR; PG8_WAIT_L(0); PG8_MMA(0, 1, At, B1); PG8_BAR;
            PG8_LDA(At, 1, 1); PG8_STAGE(PG8_SA(1, 0), a3, voffA);
            PG8_BAR; PG8_WAIT_L(0); PG8_MMA(1, 0, At, B0); PG8_BAR; PG8_SCHED;
            PG8_STAGE(PG8_SB(1, 1), b3 + hstep, voffB);
            PG8_WAIT_V(6); PG8_BAR; PG8_MMA(1, 1, At, B1); PG8_BAR;
            }
        }
        if constexpr (ALIGN_EPI) { if (wr == 0) PG8_BAR; }
        E(acc, cur, wr, wc, fr, fq);
        if (!has_next) break;
#pragma unroll
        for (int a = 0; a < 2; ++a)
#pragma unroll
            for (int b = 0; b < 2; ++b)
#pragma unroll
                for (int m = 0; m < 4; ++m)
#pragma unroll
                    for (int n = 0; n < 2; ++n) acc[a][b][m][n] = (f32x4){0.f, 0.f, 0.f, 0.f};
        cur = nxt; cA = nA; cB = nB; ++ui;
        if constexpr (ALIGN_EPI) { if (wr == 1) PG8_BAR; }
    }
    PG8_WAIT_V(0);
    if constexpr (!ALIGN_EPI) { if (wr == 0) PG8_BAR; }
    PG8_BAR;
#undef PG8_SA
#undef PG8_SB
#undef PG8_STAGE
#undef PG8_LDA
#undef PG8_LDB
#undef PG8_MMA
#undef PG8_WAIT_V
#undef PG8_WAIT_L
#undef PG8_BAR
#undef PG8_SCHED
}
}
using pg8::Unit;

typedef f32x4 Acc[2][2][4][2];

struct EpiInProj {
    static constexpr bool PERM = true;
    bf16_t *q, *k, *v, *g, *f; const float* ropec; const float* ropes;
    __device__ __forceinline__ void operator()(const Acc& acc, const Unit& u, int wr, int wc, int fr, int fq) const {
        const int pn = u.pn; bf16_t* base; int ldc, colt;
        if (pn < 2) { base = q; ldc = 512; colt = pn * 256; }
        else if (pn < 4) { base = k; ldc = 512; colt = (pn - 2) * 256; }
        else if (pn < 8) { base = v; ldc = 1024; colt = (pn - 4) * 256; }
        else if (pn < 12) { base = g; ldc = 1024; colt = (pn - 8) * 256; }
        else { base = f; ldc = 1024; colt = (pn - 12) * 256; }
        const bool rope = pn < 4;
        const int row0 = u.pm * 256 + wr * 64 + fr, col0 = colt + wc * 32 + 8 * fq;
#pragma unroll
        for (int ai = 0; ai < 2; ++ai)
#pragma unroll
            for (int m = 0; m < 4; ++m) {
                const int row = row0 + ai * 128 + m * 16;
                f32x4 cs = (f32x4){1.f, 1.f, 1.f, 1.f}, sn = (f32x4){0.f, 0.f, 0.f, 0.f};
                if (rope) { const int l = row & (SEQ - 1); const int p = (wc & 1) ? (l & 63) : (l >> 6); cs = *(const f32x4*)(ropec + p * 16 + 4 * fq); sn = *(const f32x4*)(ropes + p * 16 + 4 * fq); }
                bf16_t* rowp = base + (size_t)row * ldc + col0;
#pragma unroll
                for (int bj = 0; bj < 2; ++bj) {
                    const f32x4 t1 = acc[ai][bj][m][0], t2 = acc[ai][bj][m][1];
                    const f32x4 o1 = t1 * cs - t2 * sn, o2 = t1 * sn + t2 * cs;
                    u32x4 o; o.x = cvt_pk_bf16(o1[0], o1[1]); o.y = cvt_pk_bf16(o1[2], o1[3]); o.z = cvt_pk_bf16(o2[0], o2[1]); o.w = cvt_pk_bf16(o2[2], o2[3]);
                    *(u32x4*)(rowp + bj * 128) = o;
                }
            }
    }
};

struct EpiBf16 {
    static constexpr bool PERM = true;
    bf16_t* O; int ldc;
    __device__ __forceinline__ void operator()(const Acc& acc, const Unit& u, int wr, int wc, int fr, int fq) const {
        const int row0 = u.pm * 256 + wr * 64 + fr, col0 = u.pn * 256 + wc * 32 + 8 * fq;
#pragma unroll
        for (int ai = 0; ai < 2; ++ai)
#pragma unroll
            for (int m = 0; m < 4; ++m) {
                bf16_t* rowp = O + (size_t)(row0 + ai * 128 + m * 16) * ldc + col0;
#pragma unroll
                for (int bj = 0; bj < 2; ++bj) {
                    const f32x4 v0 = acc[ai][bj][m][0], v1 = acc[ai][bj][m][1];
                    u32x4 o; o.x = cvt_pk_bf16(v0[0], v0[1]); o.y = cvt_pk_bf16(v0[2], v0[3]); o.z = cvt_pk_bf16(v1[0], v1[1]); o.w = cvt_pk_bf16(v1[2], v1[3]);
                    *(u32x4*)(rowp + bj * 128) = o;
                }
            }
    }
};

struct EpiMerge {
    static constexpr bool PERM = true;
    const bf16_t* retd; const bf16_t* fourd; const float* bbg; bf16_t* merged;
    __device__ __forceinline__ void operator()(const Acc& acc, const Unit& u, int wr, int wc, int fr, int fq) const {
        const int row0 = u.pm * 256 + wr * 64 + fr, ch0 = u.pn * 128 + wc * 16 + 4 * fq;
        f32x4 br[2], bf[2];
#pragma unroll
        for (int bj = 0; bj < 2; ++bj) { br[bj] = *(const f32x4*)(bbg + ch0 + 64 * bj); bf[bj] = *(const f32x4*)(bbg + D + ch0 + 64 * bj); }
#pragma unroll
        for (int ai = 0; ai < 2; ++ai)
#pragma unroll
            for (int m = 0; m < 4; ++m) {
                const size_t ro = (size_t)(row0 + ai * 128 + m * 16) * D + ch0;
#pragma unroll
                for (int bj = 0; bj < 2; ++bj) {
                    const f32x4 a = acc[ai][bj][m][0] + br[bj], b = acc[ai][bj][m][1] + bf[bj];
                    const u32x2 rd = *(const u32x2*)(retd + ro + 64 * bj), fd = *(const u32x2*)(fourd + ro + 64 * bj);
                    const float o0 = sigmoidf_(a[0]) * bf_lo(rd.x) + sigmoidf_(b[0]) * bf_lo(fd.x);
                    const float o1 = sigmoidf_(a[1]) * bf_hi(rd.x) + sigmoidf_(b[1]) * bf_hi(fd.x);
                    const float o2 = sigmoidf_(a[2]) * bf_lo(rd.y) + sigmoidf_(b[2]) * bf_lo(fd.y);
                    const float o3 = sigmoidf_(a[3]) * bf_hi(rd.y) + sigmoidf_(b[3]) * bf_hi(fd.y);
                    u32x2 o; o.x = cvt_pk_bf16(o0, o1); o.y = cvt_pk_bf16(o2, o3);
                    *(u32x2*)(merged + ro + 64 * bj) = o;
                }
            }
    }
};

template <bool XIN_BF, bool OUT_BF> struct EpiResidT {
    static constexpr bool PERM = false;
    const void* xin; const float* gate; void* out;
    __device__ __forceinline__ void operator()(const Acc& acc, const Unit& u, int wr, int wc, int fr, int fq) const {
        const int row0 = u.pm * 256 + wr * 64 + fr, col0 = u.pn * 256 + wc * 32 + 4 * fq;
        const int b = (u.pm * 256) >> 13;
        f32x4 gv[2][2];
#pragma unroll
        for (int bj = 0; bj < 2; ++bj)
#pragma unroll
            for (int n = 0; n < 2; ++n) gv[bj][n] = *(const f32x4*)(gate + b * 6144 + col0 + bj * 128 + n * 16);
#pragma unroll
        for (int ai = 0; ai < 2; ++ai)
#pragma unroll
            for (int m = 0; m < 4; ++m) {
                const size_t ro = (size_t)(row0 + ai * 128 + m * 16) * D + col0;
#pragma unroll
                for (int bj = 0; bj < 2; ++bj)
#pragma unroll
                    for (int n = 0; n < 2; ++n) {
                        const size_t o_ = ro + bj * 128 + n * 16;
                        f32x4 xv;
                        if constexpr (XIN_BF) { const u32x2 q = *(const u32x2*)((const bf16_t*)xin + o_); xv = (f32x4){bf_lo(q.x), bf_hi(q.x), bf_lo(q.y), bf_hi(q.y)}; }
                        else xv = *(const f32x4*)((const float*)xin + o_);
                        const f32x4 r = xv + gv[bj][n] * acc[ai][bj][m][n];
                        if constexpr (OUT_BF) { u32x2 w; w.x = cvt_pk_bf16(r[0], r[1]); w.y = cvt_pk_bf16(r[2], r[3]); *(u32x2*)((bf16_t*)out + o_) = w; }
                        else *(f32x4*)((float*)out + o_) = r;
                    }
            }
    }
};
typedef EpiResidT<false, false> EpiResid;

struct EpiUpConv {
    static constexpr bool PERM = true;
    const float* convw; const float* convb; bf16_t* act; LAS float* wl;
    __device__ __forceinline__ void operator()(const Acc& acc, const Unit& u, int wr, int wc, int, int) const {
        const int ln_ = lane_id(), fr = ln_ & 15, fq = ln_ >> 4;
        const int b = u.pm / CONV_UNITS_PER_BATCH, up = u.pm % CONV_UNITS_PER_BATCH;
        const int ch0 = u.pn * 128 + wc * 32 + 8 * fq;
        if (wr == 0) { const int te = wc * 64 + (fq * 16 + fr), src = (te >> 7) * FFN + u.pn * 128 + (te & 127);
            wl[te] = convw[src]; wl[256 + te] = convw[NUP + src]; wl[512 + te] = convw[2 * NUP + src]; wl[768 + te] = convb[src]; }
        asm volatile("s_waitcnt lgkmcnt(0)" ::: "memory");
        __builtin_amdgcn_s_barrier();
        asm volatile("" ::: "memory");
#pragma unroll
        for (int n = 0; n < 2; ++n) {
            const int ch = ch0 + 4 * n;
#pragma unroll
            for (int ai = 0; ai < 2; ++ai) {
                const int j = 4 * up + 2 * ai + wr;
                const int t0 = 62 * j - 1 + fr;
                f32x4 ua[4];
#ifdef DBG_RAWUP
                f32x4 dbg_xp[4], dbg_xn[4];
#endif
                __builtin_amdgcn_sched_barrier(0);
#pragma unroll
                for (int part = 0; part < 2; ++part) {
                    __builtin_amdgcn_sched_barrier(0);
                    const LAS float* cw = wl + part * 128 + wc * 32 + 8 * fq + 4 * n;
                    const f32x4 w0 = *(const LAS f32x4*)(cw), w1 = *(const LAS f32x4*)(cw + 256), w2 = *(const LAS f32x4*)(cw + 512), bb = *(const LAS f32x4*)(cw + 768);
                    f32x4 xv[4];
#pragma unroll
                    for (int m = 0; m < 4; ++m) { const int t = t0 + 16 * m; const bool ok = (t >= 0) && (t < SEQ); xv[m] = ok ? acc[ai][part][m][n] : (f32x4){0.f, 0.f, 0.f, 0.f}; }
                    f32x4 x1[4];
#pragma unroll
                    for (int m = 0; m < 4; ++m)
#pragma unroll
                        for (int e = 0; e < 4; ++e) {
                            const float prv = xv[m > 0 ? m - 1 : 0][e], cur = xv[m][e];
                            const int e0 = __builtin_amdgcn_update_dpp(0, __float_as_int(prv), 0x10f, 0xf, 0xf, false);
                            x1[m][e] = __int_as_float(__builtin_amdgcn_update_dpp(e0, __float_as_int(cur), 0x111, 0xf, 0xf, false));
                        }
#pragma unroll
                    for (int m = 0; m < 4; ++m) {
                        f32x4 x2;
#pragma unroll
                        for (int e = 0; e < 4; ++e) {
                            const float prv = x1[m > 0 ? m - 1 : 0][e], cur = x1[m][e];
                            const int e0 = __builtin_amdgcn_update_dpp(0, __float_as_int(prv), 0x10f, 0xf, 0xf, false);
                            x2[e] = __int_as_float(__builtin_amdgcn_update_dpp(e0, __float_as_int(cur), 0x111, 0xf, 0xf, false));
                        }
                        const f32x4 uu = w0 * x2 + w1 * x1[m] + w2 * xv[m] + bb;
#ifdef DBG_RAWUP
                        if (part == 0) { dbg_xp[m] = x1[m]; dbg_xn[m] = x2; }
#endif
                        if (part == 0) ua[m] = uu;
                        else {
                            const int r = 16 * m + fr, t = t0 + 16 * m - 1;
                            if (r >= 2 && t < SEQ) {
                                u32x2 o; o.x = cvt_pk_bf16(gelu_tanh(ua[m][0]) * uu[0], gelu_tanh(ua[m][1]) * uu[1]); o.y = cvt_pk_bf16(gelu_tanh(ua[m][2]) * uu[2], gelu_tanh(ua[m][3]) * uu[3]);
#ifdef DBG_RAWUP
                                { o.x = cvt_pk_bf16(dbg_xp[m][0], dbg_xp[m][1]); o.y = cvt_pk_bf16(dbg_xn[m][2], dbg_xn[m][3]); }
#endif
                                *at_off<u32x2>(act, 2u * (unsigned)((b * SEQ + t) * FFN + ch)) = o;
                            }
                        }
                    }
                }
            }
        }
    }
};

struct Params {
    const float *x, *c, *ctx, *c_ctx, *w_mod, *b_mod, *norm1_w, *w_in, *dec_f, *dec_b, *w_ro, *w_fo, *w_bg, *b_bg, *w_out, *norm2_w, *w_up, *conv_w, *conv_b, *w_down, *fnorm_w;
    float* out; unsigned char* ws;
    int ph_lo, ph_hi;
};

template <int MAP> __device__ __forceinline__ int dst_row(int n) {
    if constexpr (MAP == 1) {
        if (n < 1024) { const int hd = n & ~63, d = n & 63, part = d >> 5, i = d & 31; return hd + (i >> 2) * 8 + part * 4 + (i & 3); }
        return n;
    } else if constexpr (MAP == 2) {
        const int br = n >> 10, ch = n & 1023; return (ch >> 2) * 8 + br * 4 + (ch & 3);
    } else if constexpr (MAP == 3) {
        const int part = n >= FFN ? 1 : 0, ch = n - part * FFN; return (ch >> 7) * 256 + part * 128 + (ch & 127);
    } else return n;
}
template <int MAP> __device__ __forceinline__ void transpose_item(const float* W, int K, int ldn, int nblk, bf16_t* WT, LAS float* scr, int item, int lane) {
    const int kb = item / nblk, nb = item % nblk, k0 = 64 * kb, n0 = 32 * nb;
#pragma unroll 8
    for (int i = 0; i < 32; ++i) { const int kk = 2 * i + (lane >> 5); scr[kk * 33 + (lane & 31)] = W[(size_t)(k0 + kk) * ldn + n0 + (lane & 31)]; }
    asm volatile("s_waitcnt lgkmcnt(0)" ::: "memory");
    const int c = lane & 7;
#pragma unroll
    for (int j = 0; j < 4; ++j) { const int n = (lane >> 3) + 8 * j; const LAS float* s = scr + (8 * c) * 33 + n;
        const float sc = (MAP == 1 && (n0 + n) < 512) ? 0.125f : 1.f;
        u32x4 o; o.x = cvt_pk_bf16(s[0 * 33] * sc, s[1 * 33] * sc); o.y = cvt_pk_bf16(s[2 * 33] * sc, s[3 * 33] * sc); o.z = cvt_pk_bf16(s[4 * 33] * sc, s[5 * 33] * sc); o.w = cvt_pk_bf16(s[6 * 33] * sc, s[7 * 33] * sc);
        *(u32x4*)(WT + (size_t)dst_row<MAP>(n0 + n) * K + k0 + 8 * c) = o; }
    asm volatile("s_waitcnt lgkmcnt(0)" ::: "memory");
}

__device__ __forceinline__ void phase_prep(const Params& p, LAS unsigned char* lds, const int wv) {
    const int lane = lane_id(), wave = wv, tid = wv * 64 + lane;
    const int gw = blockIdx.x * 8 + wave, NGW = gridDim.x * 8;
    unsigned char* ws = p.ws;
    {
        const int gt = blockIdx.x * 512 + tid;
        if (gt < 2048) { const int pp = gt >> 4, f = gt & 15; const float inv = exp2f(-(float)f * (13.287712379549449f / 16.f)); const float ang = (float)pp * inv;
            float rev = ang * 0.15915494309189535f; rev -= floorf(rev);
            ((float*)(ws + WS_ROPEC))[gt] = cospif(2.f * rev); ((float*)(ws + WS_ROPES))[gt] = sinpif(2.f * rev); }
        if (gt < 8192) ((float*)(ws + WS_T8192))[gt] = cospif((float)gt * (1.f / 4096.f));
    }
    {
        LAS float* scr = (LAS float*)(lds + wave * 16384);
        constexpr int I1 = 16 * 96, I2 = 16 * 32, I3 = 8 * 32, I4 = 16 * 64, I5 = 16 * 32, I6 = 16 * 176, I7 = 44 * 32;
        constexpr int NIT = I1 + I2 + I3 + I4 + I5 + I6 + I7;
        for (int it = gw; it < NIT; it += NGW) {
            int r = it;
            if (r < I1) { transpose_item<1>(p.w_in, 1024, INC, 96, (bf16_t*)(ws + WS_WIN), scr, r, lane); continue; } r -= I1;
            if (r < I2) { transpose_item<0>(p.w_ro, 1024, 1024, 32, (bf16_t*)(ws + WS_WRO), scr, r, lane); continue; } r -= I2;
            if (r < I3) { transpose_item<0>(p.w_fo, 512, 1024, 32, (bf16_t*)(ws + WS_WFO), scr, r, lane); continue; } r -= I3;
            if (r < I4) { transpose_item<2>(p.w_bg, 1024, 2048, 64, (bf16_t*)(ws + WS_WBG), scr, r, lane); continue; } r -= I4;
            if (r < I5) { transpose_item<0>(p.w_out, 1024, 1024, 32, (bf16_t*)(ws + WS_WOUT), scr, r, lane); continue; } r -= I5;
            if (r < I6) { transpose_item<3>(p.w_up, 1024, NUP, 176, (bf16_t*)(ws + WS_WUP), scr, r, lane); continue; } r -= I6;
            transpose_item<0>(p.w_down, FFN, 1024, 32, (bf16_t*)(ws + WS_WDN), scr, r, lane);
        }
    }
    __syncthreads();
    {
        LAS float* wt = (LAS float*)lds;
        LAS float* tab = (LAS float*)(lds + 32 * 129 * 4);
        if (tid < 128) tab[tid] = cospif((float)tid * (1.f / 64.f));
        bf16_t* WT = (bf16_t*)(ws + WS_WIN);
        for (int it = blockIdx.x; it < 256; it += gridDim.x) {
            const int kb = it >> 3, g = (it >> 1) & 3, hf = it & 1;
            __syncthreads();
#pragma unroll
            for (int i = 0; i < 8; ++i) { const int idx = tid + 512 * i, kk = idx >> 7, cc = idx & 127; wt[kk * 129 + cc] = p.w_in[(size_t)(kb * 32 + kk) * INC + 3072 + g * 128 + cc]; }
            __syncthreads();
            const int k = tid & 31, cg4 = tid >> 5, cp0 = hf * 64 + cg4 * 4;
            float aC[4] = {0.f, 0.f, 0.f, 0.f}, aS[4] = {0.f, 0.f, 0.f, 0.f};
            float cr[4], sr[4], ct[4], st[4];
#pragma unroll
            for (int e = 0; e < 4; ++e) { cr[e] = 1.f; sr[e] = 0.f; ct[e] = cospif((float)(cp0 + e) * (1.f / 64.f)); st[e] = sinpif((float)(cp0 + e) * (1.f / 64.f)); }
            for (int cc = 0; cc < 128; ++cc) {
                const float w = wt[k * 129 + cc];
#pragma unroll
                for (int e = 0; e < 4; ++e) { aC[e] += w * cr[e]; aS[e] += w * sr[e]; const float nc = cr[e] * ct[e] - sr[e] * st[e], ns = sr[e] * ct[e] + cr[e] * st[e]; cr[e] = nc; sr[e] = ns; }
            }
#pragma unroll
            for (int e = 0; e < 4; ++e) {
                const int n = g * 128 + cp0 + e;
                WT[(size_t)(3072 + n) * 1024 + kb * 32 + k] = (bf16_t)(cvt_pk_bf16(aC[e] * 0.0625f, 0.f) & 0xffffu);
                WT[(size_t)(3584 + n) * 1024 + kb * 32 + k] = (bf16_t)(cvt_pk_bf16(-aS[e] * 0.0625f, 0.f) & 0xffffu);
            }
        }
        __syncthreads();
    }
    {
        LAS float* sl = (LAS float*)lds;
        LAS float* red = (LAS float*)(lds + 16384);
        if (blockIdx.x < 96) {
#pragma unroll
            for (int i = 0; i < 6; ++i) { const int idx = tid + 512 * i; sl[idx] = siluf_(idx < 2048 ? p.c[idx] : p.c_ctx[idx - 2048]); }
        }
        __syncthreads();
        for (int it = blockIdx.x; it < 96; it += gridDim.x) {
            const int col = it * 64 + lane;
            float a0 = 0.f, a1 = 0.f, a2 = 0.f;
            const float* wp = p.w_mod + (size_t)(wave * 128) * 6144 + col;
#pragma unroll 16
            for (int kk = 0; kk < 128; ++kk) {
                const float wv = wp[(size_t)kk * 6144]; const int k = wave * 128 + kk;
                a0 += sl[k] * wv; a1 += sl[1024 + k] * wv; a2 += sl[2048 + k] * wv;
            }
            __syncthreads();
            red[(wave * 3 + 0) * 64 + lane] = a0; red[(wave * 3 + 1) * 64 + lane] = a1; red[(wave * 3 + 2) * 64 + lane] = a2;
            __syncthreads();
            if (wave < 3) { float sres = p.b_mod[col];
#pragma unroll
                for (int w = 0; w < 8; ++w) sres += red[(w * 3 + wave) * 64 + lane];
                ((float*)(ws + WS_MODV))[wave * 6144 + col] = sres; }
        }
        __syncthreads();
    }
}

template <int MODE> __device__ __forceinline__ void norm_row(const float* xrow, const float* w, const float* sc, const float* sh, void* orow, int lane) {
    const f32x4* xr = (const f32x4*)xrow + lane;
    f32x4 v[4]; float s = 0.f;
#pragma unroll
    for (int j = 0; j < 4; ++j) { v[j] = xr[64 * j]; s += (v[j][0] * v[j][0] + v[j][1] * v[j][1]) + (v[j][2] * v[j][2] + v[j][3] * v[j][3]); }
    const float rs = rsqrtf(wave_sum(s) * (1.f / D) + EPS);
#pragma unroll
    for (int j = 0; j < 4; ++j) {
        const int c = 4 * lane + 256 * j;
        f32x4 y = v[j] * rs * *(const f32x4*)(w + c);
        if constexpr (MODE == 0) {
            y = y * (*(const f32x4*)(sc + c) + 1.f) + *(const f32x4*)(sh + c);
            u32x2 o; o.x = cvt_pk_bf16(y[0], y[1]); o.y = cvt_pk_bf16(y[2], y[3]);
            *(u32x2*)((bf16_t*)orow + c) = o;
        } else {
#ifdef NAN_PROBE
#pragma unroll
            for (int e = 0; e < 4; ++e) if (!(fabsf(y[e]) < 1e30f)) y[e] = 1000.f;
#endif
            *(f32x4*)((float*)orow + c) = y; }
    }
}

template <int MODE> __device__ __forceinline__ void norm_row2(const float* x0, const float* x1, const float* w, const float* sc0, const float* sh0, const float* sc1, const float* sh1, void* o0, void* o1, bool rvalid1, int lane) {
    const f32x4* xr0 = (const f32x4*)x0 + lane; const f32x4* xr1 = (const f32x4*)(rvalid1 ? x1 : x0) + lane;
    f32x4 v0[4], v1[4]; float s0 = 0.f, s1 = 0.f;
#pragma unroll
    for (int j = 0; j < 4; ++j) { v0[j] = xr0[64 * j]; v1[j] = xr1[64 * j]; }
#pragma unroll
    for (int j = 0; j < 4; ++j) { s0 += (v0[j][0] * v0[j][0] + v0[j][1] * v0[j][1]) + (v0[j][2] * v0[j][2] + v0[j][3] * v0[j][3]); s1 += (v1[j][0] * v1[j][0] + v1[j][1] * v1[j][1]) + (v1[j][2] * v1[j][2] + v1[j][3] * v1[j][3]); }
#pragma unroll
    for (int o = 1; o < 64; o <<= 1) { s0 += __shfl_xor(s0, o); s1 += __shfl_xor(s1, o); }
    const float rs0 = rsqrtf(s0 * (1.f / D) + EPS), rs1 = rsqrtf(s1 * (1.f / D) + EPS);
#pragma unroll
    for (int j = 0; j < 4; ++j) {
        const int c = 4 * lane + 256 * j; const f32x4 wv = *(const f32x4*)(w + c);
        f32x4 y0 = v0[j] * rs0 * wv, y1 = v1[j] * rs1 * wv;
        if constexpr (MODE == 0) {
            y0 = y0 * (*(const f32x4*)(sc0 + c) + 1.f) + *(const f32x4*)(sh0 + c); y1 = y1 * (*(const f32x4*)(sc1 + c) + 1.f) + *(const f32x4*)(sh1 + c);
            u32x2 a; a.x = cvt_pk_bf16(y0[0], y0[1]); a.y = cvt_pk_bf16(y0[2], y0[3]); *(u32x2*)((bf16_t*)o0 + c) = a;
            if (rvalid1) { u32x2 bq; bq.x = cvt_pk_bf16(y1[0], y1[1]); bq.y = cvt_pk_bf16(y1[2], y1[3]); *(u32x2*)((bf16_t*)o1 + c) = bq; }
        } else { *(f32x4*)((float*)o0 + c) = y0; if (rvalid1) *(f32x4*)((float*)o1 + c) = y1; }
    }
}

__device__ __forceinline__ bf16x8 tr_frag(LAS unsigned char* tile, int rs, int row0, int col0, int lane) {
    const int g = lane >> 4, q = (lane & 15) >> 2, pp = lane & 3;
    LAS unsigned char* a = tile + (row0 + 8 * g + q) * rs + (col0 + 4 * pp) * 2;
    const s16x4 lo = __builtin_amdgcn_ds_read_tr16_b64_v4i16((LAS s16x4*)a);
    const s16x4 hi = __builtin_amdgcn_ds_read_tr16_b64_v4i16((LAS s16x4*)(a + 4 * rs));
    return __builtin_shufflevector(lo, hi, 0, 1, 2, 3, 4, 5, 6, 7);
}
__device__ __forceinline__ bf16x8 row_frag(LAS unsigned char* tile, int rs, int row0, int col0, int lane) {
    return *(const LAS bf16x8*)(tile + (row0 + (lane & 15)) * rs + (col0 + 8 * (lane >> 4)) * 2);
}
__device__ __forceinline__ bf16x8 scale_frag(bf16x8 v, float s) {
    const u32x4 u = __builtin_bit_cast(u32x4, v); u32x4 o;
    o.x = cvt_pk_bf16(bf_lo(u.x) * s, bf_hi(u.x) * s); o.y = cvt_pk_bf16(bf_lo(u.y) * s, bf_hi(u.y) * s);
    o.z = cvt_pk_bf16(bf_lo(u.z) * s, bf_hi(u.z) * s); o.w = cvt_pk_bf16(bf_lo(u.w) * s, bf_hi(u.w) * s);
    return __builtin_bit_cast(bf16x8, o);
}
template <int ROWS, int COLS> __device__ __forceinline__ void stage_load(u32x4 (&v)[ROWS * COLS / 8 / 512], const bf16_t* src, size_t gld, int tid) {
    constexpr int CPR = COLS / 8, N = ROWS * CPR / 512;
#pragma unroll
    for (int i = 0; i < N; ++i) { const int id = tid + 512 * i, r = id / CPR, c = id % CPR; v[i] = *(const u32x4*)(src + (size_t)r * gld + c * 8); }
}
template <int ROWS, int COLS> __device__ __forceinline__ void stage_store(LAS unsigned char* dst, int rs, const u32x4 (&v)[ROWS * COLS / 8 / 512], int tid) {
    constexpr int CPR = COLS / 8, N = ROWS * CPR / 512;
#pragma unroll
    for (int i = 0; i < N; ++i) { const int id = tid + 512 * i, r = id / CPR, c = id % CPR; *(LAS u32x4*)(dst + r * rs + c * 16) = v[i]; }
}
template <int ROWS, int COLS> __device__ __forceinline__ void stage_tile(LAS unsigned char* dst, int rs, const bf16_t* src, size_t gld, int tid) {
    static_assert((ROWS * COLS / 8) % 512 == 0, "tile pieces must divide over 512 threads");
    u32x4 v[ROWS * COLS / 8 / 512];
    stage_load<ROWS, COLS>(v, src, gld, tid); stage_store<ROWS, COLS>(dst, rs, v, tid);
}

constexpr int RSK = 144, RSV = 272;

__device__ __forceinline__ void phase_kvinc(const Params& p, LAS unsigned char* lds, const int wv, const int it_lo, const int it_hi, const int it_step) {
    const int lane = lane_id(), wave = wv, tid = wv * 64 + lane;
    const bf16_t* kb = (const bf16_t*)(p.ws + WS_K); const bf16_t* vb = (const bf16_t*)(p.ws + WS_V);
    bf16_t* kvinc = (bf16_t*)((unsigned char*)p.out + DO_KVINC);
    LAS unsigned char* Kf = lds; LAS unsigned char* Kb = lds + 128 * RSK; LAS unsigned char* Vt = lds + 2 * 128 * RSK;
    for (int it = it_lo; it < it_hi; it += it_step) {
        const int bh = it >> 6, n = it & 63, b = bh >> 3, h = bh & 7;
        const size_t tok0 = (size_t)b * SEQ + (size_t)n * CH;
        const float lgf = -__expf(p.dec_f[h]) * 1.4426950408889634f, lgb = -__expf(p.dec_b[h]) * 1.4426950408889634f;
        __syncthreads();
#pragma unroll
        for (int i = 0; i < 2; ++i) { const int id = tid + 512 * i, r = id >> 3, c = id & 7;
            const bf16x8 kv = *(const bf16x8*)(kb + (tok0 + r) * 512 + h * 64 + c * 8);
            *(LAS bf16x8*)(Kf + r * RSK + c * 16) = scale_frag(kv, exp2f(lgf * (float)(127 - r)));
            *(LAS bf16x8*)(Kb + r * RSK + c * 16) = scale_frag(kv, exp2f(lgb * (float)r)); }
        stage_tile<128, 128>(Vt, RSV, vb + tok0 * 1024 + h * 128, 1024, tid);
        __syncthreads();
        const int dir = wave >> 2, nt0 = 2 * (wave & 3);
        LAS unsigned char* Kd = dir ? Kb : Kf;
        f32x4 acc[4][2];
#pragma unroll
        for (int m = 0; m < 4; ++m) { acc[m][0] = (f32x4){0.f, 0.f, 0.f, 0.f}; acc[m][1] = (f32x4){0.f, 0.f, 0.f, 0.f}; }
#pragma unroll
        for (int ks = 0; ks < 4; ++ks) {
            const bf16x8 b0 = tr_frag(Vt, RSV, 32 * ks, 16 * nt0, lane), b1 = tr_frag(Vt, RSV, 32 * ks, 16 * nt0 + 16, lane);
#pragma unroll
            for (int m = 0; m < 4; ++m) { const bf16x8 a = tr_frag(Kd, RSK, 32 * ks, 16 * m, lane);
                acc[m][0] = __builtin_amdgcn_mfma_f32_16x16x32_bf16(a, b0, acc[m][0], 0, 0, 0);
                acc[m][1] = __builtin_amdgcn_mfma_f32_16x16x32_bf16(a, b1, acc[m][1], 0, 0, 0); }
        }
        bf16_t* o = kvinc + ((size_t)it * 2 + dir) * 8192;
#pragma unroll
        for (int m = 0; m < 4; ++m)
#pragma unroll
            for (int j = 0; j < 2; ++j) { const int dv = 16 * (nt0 + j) + (lane & 15), dk = 16 * m + 4 * (lane >> 4);
                u32x2 w; w.x = cvt_pk_bf16(acc[m][j][0], acc[m][j][1]); w.y = cvt_pk_bf16(acc[m][j][2], acc[m][j][3]);
                *(u32x2*)(o + dv * 64 + dk) = w; }
    }
}

__device__ __forceinline__ void phase_scan(const Params& p, const int wv) {
    const int tid = wv * 64 + lane_id();
    const bf16_t* kvc = (const bf16_t*)(p.ws + WS_KVC);
    const bf16_t* kvinc = (const bf16_t*)((unsigned char*)p.out + DO_KVINC);
    bf16_t* sprev = (bf16_t*)(p.ws + WS_SPREV);
    for (int it = blockIdx.x; it < 256; it += gridDim.x) {
        const int bh = it >> 4, dir = (it >> 3) & 1, sl = it & 7, b = bh >> 3, h = bh & 7;
        const int dv = 16 * sl + (tid >> 5), dk = 2 * (tid & 31);
        const float a = dir ? p.dec_b[h] : p.dec_f[h];
        const float lg = -__expf(a), gam = __expf(lg), gamC = __expf(lg * (float)CH);
        float s0 = 0.f, s1 = 0.f;
#pragma unroll 32
        for (int jj = 0; jj < CTX; ++jj) {
            const int j = dir ? (CTX - 1 - jj) : jj;
            const bf16_t* row = kvc + (size_t)(b * CTX + j) * 1536;
            const unsigned kk = *(const unsigned*)(row + h * 64 + dk); const float vv = bf2f(row[512 + h * 128 + dv]);
            s0 = gam * s0 + bf_lo(kk) * vv; s1 = gam * s1 + bf_hi(kk) * vv;
        }
#pragma unroll 16
        for (int nn = 0; nn < NCH; ++nn) {
            const int n = dir ? (NCH - 1 - nn) : nn;
            const size_t off = (((size_t)bh * NCH + n) * 2 + dir) * 8192 + dv * 64 + dk;
            const unsigned inc = *(const unsigned*)(kvinc + off);
            *(unsigned*)(sprev + off) = cvt_pk_bf16(s0, s1);
            s0 = gamC * s0 + bf_lo(inc); s1 = gamC * s1 + bf_hi(inc);
        }
    }
}

__device__ __forceinline__ void phase_retout(const Params& p, LAS unsigned char* lds, const int wv) {
    const int lane = lane_id(), wave = wv, tid = wv * 64 + lane;
    const bf16_t* qb = (const bf16_t*)(p.ws + WS_Q); const bf16_t* kb = (const bf16_t*)(p.ws + WS_K); const bf16_t* vb = (const bf16_t*)(p.ws + WS_V); const bf16_t* gb = (const bf16_t*)(p.ws + WS_G);
    const bf16_t* sprev = (const bf16_t*)(p.ws + WS_SPREV);
    bf16_t* R = (bf16_t*)((unsigned char*)p.out + DO_R);
    LAS unsigned char* Kt = lds; LAS unsigned char* Vt = Kt + 128 * RSK; LAS unsigned char* Sf = Vt + 128 * RSV; LAS unsigned char* Sb = Sf + 128 * RSK; LAS unsigned char* Pw = Sb + 128 * RSK + wave * (16 * RSV);
    u32x4 pk[2], pv[4], psf[2], psb[2]; bf16x8 pq0, pq1;
#define RET_PREFETCH(itx) do { const int bh_ = (itx) >> 6, n_ = (itx) & 63, b_ = bh_ >> 3, h_ = bh_ & 7; const size_t tk_ = (size_t)b_ * SEQ + (size_t)n_ * CH; \
        stage_load<128, 64>(pk, kb + tk_ * 512 + h_ * 64, 512, tid); stage_load<128, 128>(pv, vb + tk_ * 1024 + h_ * 128, 1024, tid); \
        stage_load<128, 64>(psf, sprev + ((size_t)(itx) * 2 + 0) * 8192, 64, tid); stage_load<128, 64>(psb, sprev + ((size_t)(itx) * 2 + 1) * 8192, 64, tid); \
        const bf16_t* qr_ = qb + (tk_ + 16 * wave + (lane & 15)) * 512 + h_ * 64 + 8 * (lane >> 4); pq0 = *(const bf16x8*)qr_; pq1 = *(const bf16x8*)(qr_ + 32); } while (0)
    if ((int)blockIdx.x < 1024) RET_PREFETCH((int)blockIdx.x);
    for (int it = blockIdx.x; it < 1024; it += gridDim.x) {
        const int bh = it >> 6, n = it & 63, b = bh >> 3, h = bh & 7;
        const size_t tok0 = (size_t)b * SEQ + (size_t)n * CH;
        const float lgf = -__expf(p.dec_f[h]) * 1.4426950408889634f, lgb = -__expf(p.dec_b[h]) * 1.4426950408889634f;
        __syncthreads();
        stage_store<128, 64>(Kt, RSK, pk, tid); stage_store<128, 128>(Vt, RSV, pv, tid); stage_store<128, 64>(Sf, RSK, psf, tid); stage_store<128, 64>(Sb, RSK, psb, tid);
        const int cl = 16 * wave + (lane & 15);
        const bf16x8 q0 = pq0, q1 = pq1;
        __syncthreads();
        { const int itn = (it + (int)gridDim.x < 1024) ? it + (int)gridDim.x : it; RET_PREFETCH(itn); }
#pragma unroll
        for (int mt = 0; mt < 8; ++mt) {
            f32x4 sc = (f32x4){0.f, 0.f, 0.f, 0.f};
            sc = __builtin_amdgcn_mfma_f32_16x16x32_bf16(row_frag(Kt, RSK, 16 * mt, 0, lane), q0, sc, 0, 0, 0);
            sc = __builtin_amdgcn_mfma_f32_16x16x32_bf16(row_frag(Kt, RSK, 16 * mt, 32, lane), q1, sc, 0, 0, 0);
            float w[4];
#pragma unroll
            for (int r = 0; r < 4; ++r) { const int s = 16 * mt + 4 * (lane >> 4) + r, d = cl - s;
                w[r] = sc[r] * (d > 0 ? exp2f(lgf * (float)d) : (d < 0 ? exp2f(lgb * (float)(-d)) : 2.f)); }
            u32x2 o; o.x = cvt_pk_bf16(w[0], w[1]); o.y = cvt_pk_bf16(w[2], w[3]);
            *(LAS u32x2*)(Pw + (lane & 15) * RSV + (16 * mt + 4 * (lane >> 4)) * 2) = o;
        }
        asm volatile("s_waitcnt lgkmcnt(0)" ::: "memory");
        f32x4 o[8];
#pragma unroll
        for (int mt = 0; mt < 8; ++mt) o[mt] = (f32x4){0.f, 0.f, 0.f, 0.f};
#pragma unroll
        for (int ks = 0; ks < 4; ++ks) {
            const bf16x8 pf = *(const LAS bf16x8*)(Pw + (lane & 15) * RSV + (32 * ks + 8 * (lane >> 4)) * 2);
#pragma unroll
            for (int mt = 0; mt < 8; ++mt) o[mt] = __builtin_amdgcn_mfma_f32_16x16x32_bf16(tr_frag(Vt, RSV, 32 * ks, 16 * mt, lane), pf, o[mt], 0, 0, 0);
        }
        {
            const float sf = exp2f(lgf * (float)(cl + 1)), sb = exp2f(lgb * (float)(CH - cl));
            const bf16x8 qf0 = scale_frag(q0, sf), qf1 = scale_frag(q1, sf), qb0 = scale_frag(q0, sb), qb1 = scale_frag(q1, sb);
#pragma unroll
            for (int mt = 0; mt < 8; ++mt) {
                o[mt] = __builtin_amdgcn_mfma_f32_16x16x32_bf16(row_frag(Sf, RSK, 16 * mt, 0, lane), qf0, o[mt], 0, 0, 0);
                o[mt] = __builtin_amdgcn_mfma_f32_16x16x32_bf16(row_frag(Sf, RSK, 16 * mt, 32, lane), qf1, o[mt], 0, 0, 0);
                o[mt] = __builtin_amdgcn_mfma_f32_16x16x32_bf16(row_frag(Sb, RSK, 16 * mt, 0, lane), qb0, o[mt], 0, 0, 0);
                o[mt] = __builtin_amdgcn_mfma_f32_16x16x32_bf16(row_frag(Sb, RSK, 16 * mt, 32, lane), qb1, o[mt], 0, 0, 0);
            }
        }
        float s = 0.f;
#pragma unroll
        for (int mt = 0; mt < 8; ++mt) s += (o[mt][0] + o[mt][1]) + (o[mt][2] + o[mt][3]);
        s += __shfl_xor(s, 16); s += __shfl_xor(s, 32);
        const float mu = s * (1.f / DV);
        float s2 = 0.f;
#pragma unroll
        for (int mt = 0; mt < 8; ++mt) { o[mt] = o[mt] - mu; s2 += (o[mt][0] * o[mt][0] + o[mt][1] * o[mt][1]) + (o[mt][2] * o[mt][2] + o[mt][3] * o[mt][3]); }
        s2 += __shfl_xor(s2, 16); s2 += __shfl_xor(s2, 32);
        const float rstd = rsqrtf(s2 * (1.f / DV) + EPS);
        const size_t ro = (tok0 + cl) * 1024 + h * 128 + 4 * (lane >> 4);
#pragma unroll
        for (int mt = 0; mt < 8; ++mt) {
            const u32x2 gg = *(const u32x2*)(gb + ro + 16 * mt);
            u32x2 w; w.x = cvt_pk_bf16(o[mt][0] * rstd * siluf_(bf_lo(gg.x)), o[mt][1] * rstd * siluf_(bf_hi(gg.x)));
            w.y = cvt_pk_bf16(o[mt][2] * rstd * siluf_(bf_lo(gg.y)), o[mt][3] * rstd * siluf_(bf_hi(gg.y)));
            *(u32x2*)(R + ro + 16 * mt) = w;
        }
    }
}

constexpr int RSX = 528;
template <int STAGE> __device__ __forceinline__ void phase_dft(const Params& p, LAS unsigned char* lds, const int wv, const int it_lo, const int it_hi, const int it_step) {
    const int lane = lane_id(), wave = wv, tid = wv * 64 + lane;
    const float* T = (const float*)(p.ws + WS_T8192);
    const bf16_t* fbuf = (const bf16_t*)(p.ws + WS_F);
    bf16_t* Y = (bf16_t*)((unsigned char*)p.out + DO_Y);
    bf16_t* Z = (bf16_t*)(p.ws + WS_Z);
    LAS unsigned char* Mt = lds; LAS unsigned char* Xt = lds + 128 * RSV;
    for (int it = it_lo; it < it_hi; it += it_step) {
        const int b = it >> 7;
        const int l2 = it & 127;
        const int l1p = (it >> 1) & 63, chalf = it & 1;
        f32x4 acc[2][8];
#pragma unroll
        for (int hh = 0; hh < 2; ++hh) {
            __syncthreads();
            if (STAGE == 0 ? (hh == 0) : true) {
#pragma unroll 8
                for (int id = tid; id < 128 * 128; id += 512) {
                    const int o = id >> 7, k = id & 127; float val;
                    if constexpr (STAGE == 0) {
                        const int rip = o >> 6, l1q = o & 63, ri = k >> 6, l1 = k & 63;
                        const int j = (l1q * (128 * l1 + l2)) & 8191;
                        const float cs = T[j], sn = T[(j + 6144) & 8191];
                        val = (rip == ri) ? cs : (rip == 0 ? sn : -sn);
                    } else {
                        const int j = (64 * ((o * k) & 127)) & 8191;
                        val = hh == 0 ? T[j] : T[(j + 6144) & 8191];
                    }
                    *(LAS bf16_t*)(Mt + o * RSV + k * 2) = (bf16_t)(cvt_pk_bf16(val * 0.125f, 0.f) & 0xffffu);
                }
            }
            {
                u32x4 xv[8];
#pragma unroll
                for (int i = 0; i < 8; ++i) { const int id = tid + 512 * i, k = id >> 5, c = id & 31;
                    if constexpr (STAGE == 0) { const int ri = k >> 6, l1 = k & 63; xv[i] = *(const u32x4*)(fbuf + ((size_t)b * SEQ + 128 * l1 + l2) * 1024 + ri * 512 + hh * 256 + c * 8); }
                    else xv[i] = *(const u32x4*)(Y + ((((size_t)b * 64 + l1p) * 2 + hh) * 128 + k) * 512 + chalf * 256 + c * 8); }
#pragma unroll
                for (int i = 0; i < 8; ++i) { const int id = tid + 512 * i, k = id >> 5, c = id & 31; *(LAS u32x4*)(Xt + k * RSX + c * 16) = xv[i]; }
            }
            __syncthreads();
            if (STAGE == 0 || hh == 0) {
#pragma unroll
                for (int i = 0; i < 2; ++i)
#pragma unroll
                    for (int nt = 0; nt < 8; ++nt) acc[i][nt] = (f32x4){0.f, 0.f, 0.f, 0.f};
            }
#pragma unroll
            for (int ks = 0; ks < 4; ++ks) {
                const bf16x8 a0 = tr_frag(Xt, RSX, 32 * ks, 32 * wave, lane), a1 = tr_frag(Xt, RSX, 32 * ks, 32 * wave + 16, lane);
#pragma unroll
                for (int nt = 0; nt < 8; ++nt) { const bf16x8 bm = row_frag(Mt, RSV, 16 * nt, 32 * ks, lane);
                    acc[0][nt] = __builtin_amdgcn_mfma_f32_16x16x32_bf16(a0, bm, acc[0][nt], 0, 0, 0);
                    acc[1][nt] = __builtin_amdgcn_mfma_f32_16x16x32_bf16(a1, bm, acc[1][nt], 0, 0, 0); }
            }
            if (STAGE == 0 || hh == 1) {
#pragma unroll
                for (int i = 0; i < 2; ++i)
#pragma unroll
                    for (int nt = 0; nt < 8; ++nt) {
                        const int o = 16 * nt + (lane & 15), chl = 32 * wave + 16 * i + 4 * (lane >> 4);
                        u32x2 w; w.x = cvt_pk_bf16(acc[i][nt][0], acc[i][nt][1]); w.y = cvt_pk_bf16(acc[i][nt][2], acc[i][nt][3]);
                        if constexpr (STAGE == 0) { const int rip = o >> 6, l1q = o & 63;
                            *(u32x2*)(Y + ((((size_t)b * 64 + l1q) * 2 + rip) * 128 + l2) * 512 + hh * 256 + chl) = w;
                        } else *(u32x2*)(Z + ((size_t)b * SEQ + l1p + 64 * o) * 512 + chalf * 256 + chl) = w;
                    }
            }
        }
    }
}

#define XB_TMO      128
#define XB_XCNT(j)  (256  + 64 * (j))
#define XB_XSUB(j)  (1280 + 64 * (j))
#define XB_XGEN(j)  (2304 + 64 * (j))
#define XB_TOP      3328
#define XB_TOPGEN   3392
#define XCD_BAR_WORDS 3456
#define XB_SPIN_CAP (1u << 18)
__device__ __forceinline__ unsigned xb_ld(unsigned* p)              { return __hip_atomic_load(p, __ATOMIC_RELAXED, __HIP_MEMORY_SCOPE_AGENT); }
__device__ __forceinline__ unsigned xb_add(unsigned* p, unsigned v) { return __hip_atomic_fetch_add(p, v, __ATOMIC_RELAXED, __HIP_MEMORY_SCOPE_AGENT); }
__device__ __forceinline__ unsigned xb_xcc_id() { return (unsigned)__builtin_amdgcn_s_getreg((3 << 11) | 20) & 0xFu; }
#define XB_SPIN(cond, bar) do { unsigned _sp = 0; while (cond) { __builtin_amdgcn_s_sleep(1); \
    if ((++_sp & 255u) == 0u) { if (xb_ld(&(bar)[XB_TMO])) break; if (_sp > XB_SPIN_CAP) { atomicAdd(&(bar)[XB_TMO], 1u); break; } } } } while (0)
struct XcdBarrier { unsigned* bar; unsigned x; volatile LAS unsigned* st; };
__device__ __forceinline__ XcdBarrier xcd_barrier_post(unsigned* bar, volatile LAS unsigned* st, bool t0) {
    XcdBarrier b; b.bar = bar; b.x = xb_xcc_id(); b.st = st;
    if (t0) (void)xb_add(&bar[XB_XCNT(b.x)], 1u);
    return b;
}
__device__ __forceinline__ void xcd_barrier_complete(unsigned* bar, unsigned x, unsigned& nloc, unsigned& nx) {
    const unsigned G = gridDim.x * gridDim.y * gridDim.z;
    unsigned sum, cnt, mine, sp = 0u;
    for (;;) {
        sum = 0u; cnt = 0u; mine = 0u;
#pragma unroll
        for (unsigned j = 0; j < 16; ++j) { const unsigned c = xb_ld(&bar[XB_XCNT(j)]); sum += c; cnt += (c > 0u) ? 1u : 0u; mine = (j == x) ? c : mine; }
        if (sum == G) break;
        __builtin_amdgcn_s_sleep(1);
        if ((++sp & 255u) == 0u) { if (xb_ld(&bar[XB_TMO])) break; if (sp > XB_SPIN_CAP) { atomicAdd(&bar[XB_TMO], 1u); break; } }
    }
    nloc = mine > 0u ? mine : 1u; nx = cnt > 0u ? cnt : 1u;
}
__device__ __forceinline__ void xcd_barrier(const XcdBarrier& b, bool t0) {
    asm volatile("s_waitcnt vmcnt(0)" ::: "memory");
    __syncthreads();
    if (t0) {
        unsigned* bar = b.bar;
        __builtin_amdgcn_s_waitcnt(0);
        unsigned nloc = b.st[0], nx = b.st[1];
        if (nloc == 0u) { xcd_barrier_complete(bar, b.x, nloc, nx); b.st[0] = nloc; b.st[1] = nx; }
        const unsigned old = xb_add(&bar[XB_XSUB(b.x)], 1u);
        const unsigned gen = old / nloc;
        if (old + 1u == (gen + 1u) * nloc) {
            __builtin_amdgcn_fence(__ATOMIC_RELEASE, "agent");
            asm volatile("s_waitcnt vmcnt(0)" ::: "memory");
            const unsigned og = xb_add(&bar[XB_TOP], 1u);
            const unsigned tg = og / nx;
            if (og + 1u == (tg + 1u) * nx) xb_add(&bar[XB_TOPGEN], 1u);
            else XB_SPIN(xb_ld(&bar[XB_TOPGEN]) == tg, bar);
            __builtin_amdgcn_fence(__ATOMIC_ACQUIRE, "agent");
            xb_add(&bar[XB_XGEN(b.x)], 1u);
            asm volatile("s_waitcnt vmcnt(0)" ::: "memory");
        } else {
            XB_SPIN(xb_ld(&bar[XB_XGEN(b.x)]) == gen, bar);
            __builtin_amdgcn_fence(__ATOMIC_ACQUIRE, "agent");
            asm volatile("s_waitcnt vmcnt(0)" ::: "memory");
        }
    }
    __syncthreads();
}

__global__ void __launch_bounds__(512, 2) mk_fwd(Params p) {
    extern __shared__ __attribute__((aligned(16))) unsigned char shm[];
    LAS unsigned char* lds = (LAS unsigned char*)shm;
    unsigned char* ws = p.ws;
    const int wv = __builtin_amdgcn_readfirstlane((int)threadIdx.x >> 6);
    const int wave = wv;
    const int gw = blockIdx.x * 8 + wave, NGW = gridDim.x * 8;
    const float* modv = (const float*)(ws + WS_MODV);
    pg8::StaticOrder S;
#if MK_MULTI
#define GRID_SYNC() do { } while (0)
#else
    cg::grid_group grid = cg::this_grid();
#define GRID_SYNC() do { asm volatile("s_waitcnt vmcnt(0) lgkmcnt(0)" ::: "memory"); grid.sync(); \
        __builtin_amdgcn_fence(__ATOMIC_ACQUIRE, "agent"); asm volatile("s_waitcnt vmcnt(0)" ::: "memory"); } while (0)
#endif
#ifndef PH_MASK
#define PH_MASK 0xffff
#endif
#define IN(k) (((PH_MASK >> (k)) & 1) && p.ph_lo <= (k) && (k) < p.ph_hi)
#if MK_MULTI
#define SEAM(k) do { } while (0)
#else
    const bool t0 = (wv == 0) && (lane_id() == 0);
    volatile LAS unsigned* xst = (volatile LAS unsigned*)(lds + 131072 + 512);
    if (t0) { xst[0] = 0u; xst[1] = 0u; }
    __syncthreads();
    const XcdBarrier XB = xcd_barrier_post((unsigned*)(ws + WS_XBAR), xst, t0);
#define SEAM(k) do { if (IN(k) && IN((k) + 1)) xcd_barrier(XB, t0); } while (0)
#endif

#if !MK_MULTI
    if (p.ph_hi < 0) GRID_SYNC();
#endif
    if (IN(0)) phase_prep(p, lds, wv);
    SEAM(0);
    if (IN(1)) {
        bf16_t* hb = (bf16_t*)(ws + WS_H);
        const int ln = lane_id();
        for (int r = gw; r < M + MC; r += 2 * NGW) {
            const int r1 = r + NGW; const bool v1 = r1 < M + MC; const int q1 = v1 ? r1 : r;
            const int i0 = r < M ? (r >> 13) : 2, i1 = q1 < M ? (q1 >> 13) : 2;
            const float* x0 = r < M ? p.x + (size_t)r * D : p.ctx + (size_t)(r - M) * D; const float* x1p = q1 < M ? p.x + (size_t)q1 * D : p.ctx + (size_t)(q1 - M) * D;
            norm_row2<0>(x0, x1p, p.norm1_w, modv + i0 * 6144 + 1024, modv + i0 * 6144, modv + i1 * 6144 + 1024, modv + i1 * 6144, hb + (size_t)r * D, hb + (size_t)q1 * D, v1, ln);
        }
    }
    SEAM(1);
    if (IN(2)) {
        EpiInProj E; E.q = (bf16_t*)(ws + WS_Q); E.k = (bf16_t*)(ws + WS_K); E.v = (bf16_t*)(ws + WS_V); E.g = (bf16_t*)(ws + WS_G); E.f = (bf16_t*)(ws + WS_F);
        E.ropec = (const float*)(ws + WS_ROPEC); E.ropes = (const float*)(ws + WS_ROPES);
        pg8::Gemm g{(const bf16_t*)(ws + WS_H), (const bf16_t*)(ws + WS_WIN), M / 256, NIN / 256, D};
        S.init(g.nM, g.nN, gridDim.x, blockIdx.x);
        pg8::gemm_phase<EpiInProj>(lds, g, S, E, wv);
    }
    SEAM(2);
    if (IN(3)) {
#if MK_MULTI
        {
            EpiBf16 E; E.O = (bf16_t*)(ws + WS_KVC); E.ldc = 1536;
            pg8::Gemm g{(const bf16_t*)(ws + WS_H) + (size_t)M * D, (const bf16_t*)(ws + WS_WIN) + (size_t)512 * D, MC / 256, 1536 / 256, D};
            S.init(g.nM, g.nN, gridDim.x, (int)gridDim.x - 1 - (int)blockIdx.x);
            pg8::gemm_phase<EpiBf16>(lds, g, S, E, wv);
        }
        phase_kvinc(p, lds, wv, (int)blockIdx.x, 1024, (int)gridDim.x);
        phase_dft<0>(p, lds, wv, (int)blockIdx.x, 256, (int)gridDim.x);
#else
        {
            EpiBf16 E; E.O = (bf16_t*)(ws + WS_KVC); E.ldc = 1536;
            pg8::Gemm g{(const bf16_t*)(ws + WS_H) + (size_t)M * D, (const bf16_t*)(ws + WS_WIN) + (size_t)512 * D, MC / 256, 1536 / 256, D};
            S.init(g.nM, g.nN, gridDim.x, (int)gridDim.x - 1 - (int)blockIdx.x);
            pg8::gemm_phase<EpiBf16>(lds, g, S, E, wv);
        }
        unsigned* qctr = (unsigned*)(ws + WS_XBAR) + 3600;
        volatile LAS unsigned* qslot = (volatile LAS unsigned*)(lds + 131072 + 640);
        for (;;) {
            __syncthreads();
            if (t0) qslot[0] = __hip_atomic_fetch_add(qctr, 1u, __ATOMIC_RELAXED, __HIP_MEMORY_SCOPE_AGENT);
            __syncthreads();
            const int id = __builtin_amdgcn_readfirstlane((int)qslot[0]);
            if (id >= 256 + 1024) break;
            if (id < 256) phase_dft<0>(p, lds, wv, id, id + 1, 1);
            else phase_kvinc(p, lds, wv, id - 256, id - 255, 1);
        }
#endif
    }
    SEAM(3);
    if (IN(4)) { phase_scan(p, wv); phase_dft<1>(p, lds, wv, (int)blockIdx.x, 256, (int)gridDim.x); }
    SEAM(4);
    if (IN(5)) phase_retout(p, lds, wv);
    SEAM(5);
    if (IN(6)) {
        {
            EpiBf16 E; E.O = (bf16_t*)(ws + WS_RETD); E.ldc = D;
            pg8::Gemm g{(const bf16_t*)((unsigned char*)p.out + DO_R), (const bf16_t*)(ws + WS_WRO), M / 256, D / 256, D};
            S.init(g.nM, g.nN, gridDim.x, blockIdx.x);
            pg8::gemm_phase<EpiBf16>(lds, g, S, E, wv);
        }
        {
            EpiBf16 E; E.O = (bf16_t*)(ws + WS_FOURD); E.ldc = D;
            pg8::Gemm g{(const bf16_t*)(ws + WS_Z), (const bf16_t*)(ws + WS_WFO), M / 256, D / 256, 512};
            S.init(g.nM, g.nN, gridDim.x, blockIdx.x);
            pg8::gemm_phase<EpiBf16>(lds, g, S, E, wv);
        }
    }
    SEAM(6);
    if (IN(7)) {
        EpiMerge E; E.retd = (const bf16_t*)(ws + WS_RETD); E.fourd = (const bf16_t*)(ws + WS_FOURD); E.bbg = p.b_bg; E.merged = (bf16_t*)(ws + WS_MERGED);
        pg8::Gemm g{(const bf16_t*)(ws + WS_H), (const bf16_t*)(ws + WS_WBG), M / 256, 2048 / 256, D};
        S.init(g.nM, g.nN, gridDim.x, blockIdx.x);
        pg8::gemm_phase<EpiMerge>(lds, g, S, E, wv);
    }
    SEAM(7);
    if (IN(8)) {
        EpiResidT<false, true> E; E.xin = (const void*)p.x; E.gate = modv + 2048; E.out = (void*)(ws + WS_X1);
        pg8::Gemm g{(const bf16_t*)(ws + WS_MERGED), (const bf16_t*)(ws + WS_WOUT), M / 256, D / 256, D};
        S.init(g.nM, g.nN, gridDim.x, blockIdx.x);
        pg8::gemm_phase<EpiResidT<false, true>>(lds, g, S, E, wv);
    }
    SEAM(8);
    if (IN(9)) {
        bf16_t* hb = (bf16_t*)(ws + WS_H); const bf16_t* x1 = (const bf16_t*)(ws + WS_X1);
        const int ln = lane_id();
        for (int r = gw; r < M; r += 2 * NGW) {
            const int r1 = r + NGW; const bool v1 = r1 < M; const int q1 = v1 ? r1 : r; const int b0 = r >> 13, b1 = q1 >> 13;
            u32x2 a[4], c[4]; f32x4 fa[4], fc[4]; float s0 = 0.f, s1 = 0.f;
#pragma unroll
            for (int j = 0; j < 4; ++j) { a[j] = *(const u32x2*)(x1 + (size_t)r * D + 4 * ln + 256 * j); c[j] = *(const u32x2*)(x1 + (size_t)q1 * D + 4 * ln + 256 * j); }
#pragma unroll
            for (int j = 0; j < 4; ++j) {
                fa[j] = (f32x4){bf_lo(a[j].x), bf_hi(a[j].x), bf_lo(a[j].y), bf_hi(a[j].y)}; fc[j] = (f32x4){bf_lo(c[j].x), bf_hi(c[j].x), bf_lo(c[j].y), bf_hi(c[j].y)};
                s0 += (fa[j][0] * fa[j][0] + fa[j][1] * fa[j][1]) + (fa[j][2] * fa[j][2] + fa[j][3] * fa[j][3]);
                s1 += (fc[j][0] * fc[j][0] + fc[j][1] * fc[j][1]) + (fc[j][2] * fc[j][2] + fc[j][3] * fc[j][3]);
            }
#pragma unroll
            for (int o = 1; o < 64; o <<= 1) { s0 += __shfl_xor(s0, o); s1 += __shfl_xor(s1, o); }
            const float rs0 = rsqrtf(s0 * (1.f / D) + EPS), rs1 = rsqrtf(s1 * (1.f / D) + EPS);
#pragma unroll
            for (int j = 0; j < 4; ++j) {
                const int cidx = 4 * ln + 256 * j; const f32x4 wv_ = *(const f32x4*)(p.norm2_w + cidx);
                const f32x4 y0 = fa[j] * rs0 * wv_ * (*(const f32x4*)(modv + b0 * 6144 + 4096 + cidx) + 1.f) + *(const f32x4*)(modv + b0 * 6144 + 3072 + cidx);
                const f32x4 y1 = fc[j] * rs1 * wv_ * (*(const f32x4*)(modv + b1 * 6144 + 4096 + cidx) + 1.f) + *(const f32x4*)(modv + b1 * 6144 + 3072 + cidx);
                u32x2 w0; w0.x = cvt_pk_bf16(y0[0], y0[1]); w0.y = cvt_pk_bf16(y0[2], y0[3]); *(u32x2*)(hb + (size_t)r * D + cidx) = w0;
                if (v1) { u32x2 w1; w1.x = cvt_pk_bf16(y1[0], y1[1]); w1.y = cvt_pk_bf16(y1[2], y1[3]); *(u32x2*)(hb + (size_t)q1 * D + cidx) = w1; }
            }
        }
    }
    SEAM(9);
    if (IN(10)) {
        EpiUpConv E; E.convw = p.conv_w; E.convb = p.conv_b; E.act = (bf16_t*)(ws + WS_ACT); E.wl = (LAS float*)(lds + 131072 + 1024);
        pg8::Gemm g{(const bf16_t*)(ws + WS_H), (const bf16_t*)(ws + WS_WUP), CONV_NM, NUP / 256, D};
        S.init(g.nM, g.nN, gridDim.x, blockIdx.x);
        pg8::gemm_phase<EpiUpConv, true>(lds, g, S, E, wv);
    }
    SEAM(10);
    if (IN(11)) {
        EpiResidT<true, true> E; E.xin = (const void*)(ws + WS_X1); E.gate = modv + 5120; E.out = (void*)(ws + WS_X2B);
        pg8::Gemm g{(const bf16_t*)(ws + WS_ACT), (const bf16_t*)(ws + WS_WDN), M / 256, D / 256, FFN};
        S.init(g.nM, g.nN, gridDim.x, blockIdx.x);
        pg8::gemm_phase<EpiResidT<true, true>>(lds, g, S, E, wv);
    }
    SEAM(11);
    if (IN(12)) {
        const int ln = lane_id(); const bf16_t* x2 = (const bf16_t*)(ws + WS_X2B);
        for (int r = gw; r < M; r += 2 * NGW) {
            const int r1 = r + NGW; const bool v1 = r1 < M; const int q1 = v1 ? r1 : r;
            u32x2 a[4], c[4]; f32x4 fa[4], fc[4]; float s0 = 0.f, s1 = 0.f;
#pragma unroll
            for (int j = 0; j < 4; ++j) { a[j] = *(const u32x2*)(x2 + (size_t)r * D + 4 * ln + 256 * j); c[j] = *(const u32x2*)(x2 + (size_t)q1 * D + 4 * ln + 256 * j); }
#pragma unroll
            for (int j = 0; j < 4; ++j) {
                fa[j] = (f32x4){bf_lo(a[j].x), bf_hi(a[j].x), bf_lo(a[j].y), bf_hi(a[j].y)}; fc[j] = (f32x4){bf_lo(c[j].x), bf_hi(c[j].x), bf_lo(c[j].y), bf_hi(c[j].y)};
                s0 += (fa[j][0] * fa[j][0] + fa[j][1] * fa[j][1]) + (fa[j][2] * fa[j][2] + fa[j][3] * fa[j][3]);
                s1 += (fc[j][0] * fc[j][0] + fc[j][1] * fc[j][1]) + (fc[j][2] * fc[j][2] + fc[j][3] * fc[j][3]);
            }
#pragma unroll
            for (int o = 1; o < 64; o <<= 1) { s0 += __shfl_xor(s0, o); s1 += __shfl_xor(s1, o); }
            const float rs0 = rsqrtf(s0 * (1.f / D) + EPS), rs1 = rsqrtf(s1 * (1.f / D) + EPS);
#pragma unroll
            for (int j = 0; j < 4; ++j) {
                const int cidx = 4 * ln + 256 * j; const f32x4 wv_ = *(const f32x4*)(p.fnorm_w + cidx);
                *(f32x4*)(p.out + (size_t)r * D + cidx) = fa[j] * rs0 * wv_;
                if (v1) *(f32x4*)(p.out + (size_t)q1 * D + cidx) = fc[j] * rs1 * wv_;
            }
        }
    }
}

constexpr int N_PHASES = 13;

extern "C" void kernel_launch(void* const* d_in, const int* in_sizes, int n_in, void* d_out, int out_size, void* d_ws, size_t ws_size, hipStream_t stream) {
    static int grid = 0;
    if (grid == 0) {
        int dev = 0, cus = 0, per_cu = 0;
        if (hipGetDevice(&dev) != hipSuccess || hipDeviceGetAttribute(&cus, hipDeviceAttributeMultiprocessorCount, dev) != hipSuccess) { fprintf(stderr, "kernel_launch: device query failed\n"); grid = -1; return; }
        if (hipFuncSetAttribute((const void*)mk_fwd, hipFuncAttributeMaxDynamicSharedMemorySize, LDS_BYTES) != hipSuccess) { fprintf(stderr, "kernel_launch: hipFuncSetAttribute failed\n"); grid = -1; return; }
        if (hipOccupancyMaxActiveBlocksPerMultiprocessor(&per_cu, (const void*)mk_fwd, 512, LDS_BYTES) != hipSuccess || per_cu < 1) { fprintf(stderr, "kernel_launch: occupancy query says %d\n", per_cu); per_cu = 1; }
        (void)hipGetLastError();
        grid = cus * 1;
        if (ws_size < 256 * MiB) { fprintf(stderr, "kernel_launch: workspace too small (%zu)\n", ws_size); grid = -1; return; }
    }
    if (grid < 0) return;
    Params p{};
    p.x = (const float*)d_in[0]; p.c = (const float*)d_in[1]; p.ctx = (const float*)d_in[2]; p.c_ctx = (const float*)d_in[3]; p.w_mod = (const float*)d_in[4]; p.b_mod = (const float*)d_in[5];
    p.norm1_w = (const float*)d_in[6]; p.w_in = (const float*)d_in[7]; p.dec_f = (const float*)d_in[8]; p.dec_b = (const float*)d_in[9]; p.w_ro = (const float*)d_in[10]; p.w_fo = (const float*)d_in[11];
    p.w_bg = (const float*)d_in[12]; p.b_bg = (const float*)d_in[13]; p.w_out = (const float*)d_in[14]; p.norm2_w = (const float*)d_in[15]; p.w_up = (const float*)d_in[16]; p.conv_w = (const float*)d_in[17];
    p.conv_b = (const float*)d_in[18]; p.w_down = (const float*)d_in[19]; p.fnorm_w = (const float*)d_in[20];
    p.out = (float*)d_out; p.ws = (unsigned char*)d_ws;
#if MK_MULTI
    for (int ph = 0; ph < N_PHASES; ++ph) {
        p.ph_lo = ph; p.ph_hi = ph + 1;
        hipLaunchKernelGGL(mk_fwd, dim3(grid), dim3(512), LDS_BYTES, stream, p);
#ifdef DBG_CHECK
        int* fl = (int*)((unsigned char*)d_ws + 3 * MiB);
        if (ph == 0) { hipMemsetAsync(fl, 0x3f, 4, stream); hipMemsetAsync(fl + 1, 0, 4, stream); hipMemsetAsync(fl + 32, 0, 1024, stream); }
#define VER(id) hipLaunchKernelGGL(dbg_verify, dim3(64), dim3(128), 0, stream, p, id, fl)
        if (ph == 0) VER(1);
        if (ph == 1) VER(2);
        if (ph == 2) { VER(3); VER(4); VER(5); }
        if (ph == 3) { VER(6); VER(7); }
        if (ph == 4) { VER(8); VER(9); }
        if (ph == 5) VER(10);
        if (ph == 6) VER(11);
        if (ph == 7) VER(12);
        if (ph == 8) VER(13);
        if (ph == 9) VER(14);
        if (ph == 10) VER(15);
        if (ph == 11) { VER(16); VER(17); }
        if (ph == 12) hipLaunchKernelGGL(dbg_fin, dim3(16384), dim3(256), 0, stream, (float*)d_out, (const int*)fl);
#endif
    }
#else
#if defined(REP_LO)
    const int los[2] = {0, REP_LO}, his[2] = {REP_HI, N_PHASES};
    for (int li = 0; li < 2; ++li) {
        p.ph_lo = los[li]; p.ph_hi = his[li];
        (void)hipMemsetAsync((unsigned char*)d_ws + WS_XBAR, 0, 16384, stream);
        void* args[] = {&p};
        hipError_t e = hipLaunchCooperativeKernel((const void*)mk_fwd, dim3(grid), dim3(512), args, LDS_BYTES, stream);
        if (e != hipSuccess) fprintf(stderr, "kernel_launch: cooperative launch failed: %s (grid %d)\n", hipGetErrorString(e), grid);
    }
#else
    (void)hipMemsetAsync((unsigned char*)d_ws + WS_XBAR, 0, 16384, stream);
    p.ph_lo = 0; p.ph_hi = N_PHASES;
    void* args[] = {&p};
    hipError_t e = hipLaunchCooperativeKernel((const void*)mk_fwd, dim3(grid), dim3(512), args, LDS_BYTES, stream);
    if (e != hipSuccess) fprintf(stderr, "kernel_launch: cooperative launch failed: %s (grid %d)\n", hipGetErrorString(e), grid);
#endif
#endif
}
```

```cpp
#include <hip/hip_runtime.h>
#include <hip/hip_cooperative_groups.h>
#include <cstdio>
#include <cstdint>
namespace cg = cooperative_groups;

#ifndef MK_MULTI
#define MK_MULTI 0
#endif

#define LAS __attribute__((address_space(3)))
typedef unsigned short bf16_t;
typedef short bf16x8 __attribute__((ext_vector_type(8)));
typedef short s16x4 __attribute__((ext_vector_type(4)));
typedef float f32x4 __attribute__((ext_vector_type(4)));
typedef float f32x2 __attribute__((ext_vector_type(2)));
typedef unsigned u32x4 __attribute__((ext_vector_type(4)));
typedef unsigned u32x2 __attribute__((ext_vector_type(2)));

constexpr int D = 1024, NB = 2, SEQ = 8192, M = NB * SEQ, CTX = 256, MC = NB * CTX;
constexpr int NH = 8, DK = 64, DV = 128, CH = 128, NCH = SEQ / CH;
constexpr int INC = 3584, FFN = 2816, NUP = 2 * FFN;
constexpr int NIN = 4096;
constexpr float EPS = 1e-6f;
constexpr int CONV_UNITS_PER_BATCH = 34, CONV_NM = 2 * CONV_UNITS_PER_BATCH;

constexpr size_t MiB = 1u << 20;
constexpr size_t WS_MODV = 0;
constexpr size_t WS_ROPEC = 128 * 1024;
constexpr size_t WS_ROPES = 160 * 1024;
constexpr size_t WS_T8192 = 192 * 1024;
constexpr size_t WS_XBAR = 3 * MiB + 65536;
constexpr size_t WS_KVC = 1 * MiB;
constexpr size_t WS_WIN = 4 * MiB;
constexpr size_t WS_WRO = 12 * MiB;
constexpr size_t WS_WFO = 14 * MiB;
constexpr size_t WS_WBG = 15 * MiB;
constexpr size_t WS_WOUT = 19 * MiB;
constexpr size_t WS_WUP = 21 * MiB;
constexpr size_t WS_WDN = 32 * MiB;
constexpr size_t WS_H = 38 * MiB;
constexpr size_t WS_Q = 72 * MiB;
constexpr size_t WS_K = 88 * MiB;
constexpr size_t WS_V = 104 * MiB;
constexpr size_t WS_G = 136 * MiB;
constexpr size_t WS_F = 168 * MiB;
constexpr size_t WS_Z = 200 * MiB;
constexpr size_t WS_X1 = 72 * MiB;
constexpr size_t WS_RETD = 72 * MiB;
constexpr size_t WS_FOURD = 104 * MiB;
constexpr size_t WS_MERGED = 136 * MiB;
constexpr size_t WS_SPREV = 216 * MiB;
constexpr size_t WS_X2B = 224 * MiB;
constexpr size_t WS_ACT = 136 * MiB;
constexpr size_t DO_KVINC = 0;
constexpr size_t DO_Y = 32 * MiB;
constexpr size_t DO_R = 0;

constexpr int LDS_BYTES = 147456;

typedef __bf16 bf16x2_t __attribute__((ext_vector_type(2)));
__device__ __forceinline__ unsigned cvt_pk_bf16(float lo, float hi) { const f32x2 v = {lo, hi}; const bf16x2_t b = __builtin_convertvector(v, bf16x2_t); return __builtin_bit_cast(unsigned, b); }
__device__ __forceinline__ float bf_lo(unsigned u) { return __uint_as_float(u << 16); }
__device__ __forceinline__ float bf_hi(unsigned u) { return __uint_as_float(u & 0xffff0000u); }
__device__ __forceinline__ float bf2f(bf16_t b) { return __uint_as_float(((unsigned)b) << 16); }
__device__ __forceinline__ float sigmoidf_(float x) { return 1.f / (1.f + __expf(-x)); }
__device__ __forceinline__ float siluf_(float x) { return x / (1.f + __expf(-x)); }
__device__ __forceinline__ float gelu_tanh(float a) { const float u = 0.7978845608028654f * (a + 0.044715f * a * a * a); return a / (1.f + __expf(-2.f * u)); }
template <class T> __device__ __forceinline__ T ld_nt(const T* p) { return __builtin_nontemporal_load(p); }
template <class T> __device__ __forceinline__ void st_nt(T* p, T v) { __builtin_nontemporal_store(v, p); }
template <class T> __device__ __forceinline__ T* at_off(const void* base, unsigned byte_off) { return (T*)((char*)base + byte_off); }
__device__ __forceinline__ int lane_id() { int r; asm volatile("v_mbcnt_lo_u32_b32 %0, -1, 0\n\tv_mbcnt_hi_u32_b32 %0, -1, %0" : "=v"(r)); return r; }
__device__ __forceinline__ float wave_sum(float v) {
#pragma unroll
    for (int o = 1; o < 64; o <<= 1) v += __shfl_xor(v, o);
    return v;
}

namespace pg8 {
constexpr int BM = 256, BK = 64, HALF = 128, HTB = HALF * BK * 2, STAGE_BYTES = 8 * HTB, NXCD = 8, WGM = 8;
__host__ __device__ __forceinline__ int lds_byte(int r, int c) { const int st = (r >> 4) * 2 + (c >> 5), rr = r & 15, cc = c & 31, ob = rr * 64 + cc * 2; return st * 1024 + (ob ^ (((ob >> 9) & 1) << 5)); }
__host__ __device__ __forceinline__ void stage_rc(int b, int& R, int& C) { const int st = b / 1024, sb = b % 1024, swz = sb ^ (((sb >> 9) & 1) << 5); R = (st >> 1) * 16 + swz / 64; C = (st & 1) * 32 + (swz % 64) / 2; }
__host__ __device__ __forceinline__ int perm32(int rho) { const int n = rho >> 4, i = rho & 15; return 8 * (i >> 2) + 4 * n + (i & 3); }

struct Unit { int pm, pn; };
struct Gemm { const bf16_t* A; const bf16_t* Bt; int nM, nN, K; };

struct StaticOrder {
    int nM, nN, nwg, G, c;
    __device__ void init(int nM_, int nN_, int G_, int c_) { nM = nM_; nN = nN_; nwg = nM * nN; G = G_; c = c_; }
    __device__ bool next(int i, Unit& u) const {
        const long L = (long)i * G + c; if (L >= nwg) return false;
        int wgid = (int)L; { const int q = nwg / NXCD, r = nwg % NXCD, xcd = wgid % NXCD, off = wgid / NXCD; wgid = (xcd < r ? xcd * (q + 1) : r * (q + 1) + (xcd - r) * q) + off; }
        const int nig = WGM * nN, gid = wgid / nig, fm = gid * WGM, gsz = (nM - fm) < WGM ? (nM - fm) : WGM;
        u.pm = fm + ((wgid % nig) % gsz); u.pn = (wgid % nig) / gsz; return true;
    }
};

template <bool CONVA> __device__ __forceinline__ const char* a_panel(const Gemm& g, int pm) {
    if constexpr (CONVA) { const int b = pm / CONV_UNITS_PER_BATCH, u = pm % CONV_UNITS_PER_BATCH; return (const char*)g.A + ((long)b * SEQ + 248L * u - 1L) * (long)g.K * 2L; }
    else return (const char*)g.A + (size_t)pm * (size_t)(BM * 2) * g.K;
}

template <class Epi, bool CONVA = false, bool ALIGN_EPI = true, bool SP2 = true>
__device__ __forceinline__ void gemm_phase(LAS unsigned char* lds, const Gemm g, const StaticOrder& S, const Epi& E, const int wv) {
    const int lane = lane_id(), tid = wv * 64 + lane, wid = wv, wr = wid >> 2, wc = wid & 3, fr = lane & 15, fq = lane >> 4;
    const int K = g.K, nt = K / BK;
    unsigned voffA[2], voffB[2];
#pragma unroll
    for (int i = 0; i < 2; ++i) { int R, C; stage_rc(tid * 16 + i * 8192, R, C); const int Rb = Epi::PERM ? ((R & ~31) + perm32(R & 31)) : R;
        const int Ra = CONVA ? ((R >> 6) * 62 + (R & 63)) : R;
        voffA[i] = (unsigned)(Ra * K + C) * 2u; voffB[i] = (unsigned)(Rb * K + C) * 2u; }
    const size_t kstep = (size_t)(BK * 2);
    const size_t hstep = (size_t)HALF * K * 2;
    const size_t hstepA = CONVA ? (size_t)124 * K * 2 : hstep;
    const size_t tstep = 2 * hstep;
    const unsigned ldsw = (unsigned)wid * 1024u;
    const int aoff = lds_byte(wr * 64 + fr, fq * 8), boff = lds_byte(wc * 32 + fr, fq * 8);
#define PG8_SA(b, h) (((b) * 2 + (h)) * HTB)
#define PG8_SB(b, h) ((4 + (b) * 2 + (h)) * HTB)
#define PG8_STAGE(bufoff, gbase, voff) do { _Pragma("unroll") for (int _i = 0; _i < 2; ++_i) \
        __builtin_amdgcn_global_load_lds((const unsigned*)((const char*)(gbase) + (voff)[_i]), (LAS unsigned*)(lds + (bufoff) + ldsw + _i * 8192), 16, 0, 0); } while (0)
#define PG8_LDA(dst, b, h) do { _Pragma("unroll") for (int m = 0; m < 4; ++m) _Pragma("unroll") for (int k = 0; k < 2; ++k) dst[m][k] = *(const LAS bf16x8*)(lds + PG8_SA(b, h) + aoff + m * 2048 + k * 1024); } while (0)
#define PG8_LDB(dst, b, h) do { _Pragma("unroll") for (int n = 0; n < 2; ++n) _Pragma("unroll") for (int k = 0; k < 2; ++k) dst[n][k] = *(const LAS bf16x8*)(lds + PG8_SB(b, h) + boff + n * 2048 + k * 1024); } while (0)
#define PG8_MMA(ai, bj, At, Bt) do { __builtin_amdgcn_s_setprio(1); _Pragma("unroll") for (int m = 0; m < 4; ++m) _Pragma("unroll") for (int n = 0; n < 2; ++n) _Pragma("unroll") for (int k = 0; k < 2; ++k) \
        acc[ai][bj][m][n] = __builtin_amdgcn_mfma_f32_16x16x32_bf16(Bt[n][k], At[m][k], acc[ai][bj][m][n], 0, 0, 0); __builtin_amdgcn_s_setprio(0); } while (0)
#define PG8_WAIT_V(n) asm volatile("s_waitcnt vmcnt(" #n ")" ::: "memory")
#define PG8_WAIT_L(n) asm volatile("s_waitcnt lgkmcnt(" #n ")" ::: "memory")
#define PG8_BAR __builtin_amdgcn_s_barrier()
#define PG8_SCHED __builtin_amdgcn_sched_barrier(0)
    Unit cur, nxt; int ui = 0;
    if (!S.next(0, cur)) return;
    f32x4 acc[2][2][4][2];
#pragma unroll
    for (int a = 0; a < 2; ++a)
#pragma unroll
        for (int b = 0; b < 2; ++b)
#pragma unroll
            for (int m = 0; m < 4; ++m)
#pragma unroll
                for (int n = 0; n < 2; ++n) acc[a][b][m][n] = (f32x4){0.f, 0.f, 0.f, 0.f};
    bf16x8 At[4][2], B0[2][2], B1[2][2];
    const char* cA = a_panel<CONVA>(g, cur.pm); const char* cB = (const char*)g.Bt + (size_t)cur.pn * tstep;
    if constexpr (SP2) {
        PG8_STAGE(PG8_SB(0, 0), cB, voffB); PG8_STAGE(PG8_SB(0, 1), cB + hstep, voffB); PG8_STAGE(PG8_SA(0, 0), cA, voffA); PG8_STAGE(PG8_SA(0, 1), cA + hstepA, voffA);
        if (wr == 1) PG8_BAR;
        PG8_WAIT_V(2); PG8_BAR;
        PG8_STAGE(PG8_SB(1, 0), cB + kstep, voffB); PG8_STAGE(PG8_SA(1, 0), cA + kstep, voffA); PG8_STAGE(PG8_SB(1, 1), cB + hstep + kstep, voffB);
        PG8_WAIT_V(6); PG8_BAR;
    } else {
        PG8_STAGE(PG8_SB(0, 0), cB, voffB); PG8_STAGE(PG8_SA(0, 0), cA, voffA); PG8_STAGE(PG8_SB(0, 1), cB + hstep, voffB); PG8_STAGE(PG8_SA(0, 1), cA + hstepA, voffA);
        if (wr == 1) PG8_BAR;
        PG8_WAIT_V(4); PG8_BAR;
        PG8_STAGE(PG8_SB(1, 0), cB + kstep, voffB); PG8_STAGE(PG8_SA(1, 0), cA + kstep, voffA); PG8_STAGE(PG8_SB(1, 1), cB + hstep + kstep, voffB);
        PG8_WAIT_V(6); PG8_BAR;
    }
    for (;;) {
        const bool has_next = S.next(ui + 1, nxt);
        const char* nA = has_next ? a_panel<CONVA>(g, nxt.pm) : cA; const char* nB = has_next ? (const char*)g.Bt + (size_t)nxt.pn * tstep : cB;
        for (int t = 0; t < nt; t += 2) {
            const bool last = (t == nt - 2);
            const char* a1 = cA + (size_t)(t + 1) * kstep;
            const char* a2 = last ? nA : cA + (size_t)(t + 2) * kstep; const char* b2 = last ? nB : cB + (size_t)(t + 2) * kstep;
            const char* a3 = a2 + kstep; const char* b3 = b2 + kstep;
            if constexpr (SP2) {
            PG8_LDB(B0, 0, 0); PG8_LDB(B1, 0, 1); PG8_SCHED; PG8_LDA(At, 0, 0); PG8_STAGE(PG8_SA(1, 1), a1 + hstepA, voffA);
            PG8_WAIT_V(8); PG8_WAIT_L(0); PG8_BAR; PG8_MMA(0, 0, At, B0); PG8_MMA(0, 1, At, B1); PG8_BAR; PG8_SCHED;
            PG8_LDA(At, 0, 1); PG8_STAGE(PG8_SB(0, 0), b2, voffB); PG8_STAGE(PG8_SB(0, 1), b2 + hstep, voffB); PG8_STAGE(PG8_SA(0, 0), a2, voffA);
            PG8_WAIT_V(8); PG8_WAIT_L(0); PG8_BAR; PG8_MMA(1, 0, At, B0); PG8_MMA(1, 1, At, B1); PG8_BAR; PG8_SCHED;
            PG8_LDB(B0, 1, 0); PG8_LDB(B1, 1, 1); PG8_SCHED; PG8_LDA(At, 1, 0); PG8_STAGE(PG8_SA(0, 1), a2 + hstepA, voffA);
            PG8_WAIT_V(8); PG8_WAIT_L(0); PG8_BAR; PG8_MMA(0, 0, At, B0); PG8_MMA(0, 1, At, B1); PG8_BAR; PG8_SCHED;
            PG8_LDA(At, 1, 1); PG8_STAGE(PG8_SB(1, 0), b3, voffB); PG8_STAGE(PG8_SB(1, 1), b3 + hstep, voffB); PG8_STAGE(PG8_SA(1, 0), a3, voffA);
            PG8_WAIT_V(8); PG8_WAIT_L(0); PG8_BAR; PG8_MMA(1, 0, At, B0); PG8_MMA(1, 1, At, B1); PG8_BAR; PG8_SCHED;
            } else {
            PG8_LDB(B0, 0, 0); PG8_SCHED; PG8_LDA(At, 0, 0); PG8_STAGE(PG8_SA(1, 1), a1 + hstepA, voffA);
            PG8_WAIT_L(8); PG8_BAR; PG8_WAIT_L(0); PG8_MMA(0, 0, At, B0); PG8_BAR; PG8_SCHED;
            PG8_LDB(B1, 0, 1); PG8_STAGE(PG8_SB(0, 0), b2, voffB);
            PG8_BAR; PG8_WAIT_L(0); PG8_MMA(0, 1, At, B1); PG8_BAR;
            PG8_LDA(At, 0, 1); PG8_STAGE(PG8_SA(0, 0), a2, voffA);
            PG8_BAR; PG8_WAIT_L(0); PG8_MMA(1, 0, At, B0); PG8_BAR; PG8_SCHED;
            PG8_STAGE(PG8_SB(0, 1), b2 + hstep, voffB);
            PG8_WAIT_V(6); PG8_BAR; PG8_MMA(1, 1, At, B1); PG8_BAR;
            PG8_LDB(B0, 1, 0); PG8_SCHED; PG8_LDA(At, 1, 0); PG8_STAGE(PG8_SA(0, 1), a2 + hstepA, voffA);
            PG8_WAIT_L(8); PG8_BAR; PG8_WAIT_L(0); PG8_MMA(0, 0, At, B0); PG8_BAR; PG8_SCHED;
            PG8_LDB(B1, 1, 1); PG8_STAGE(PG8_SB(1, 0), b3, voffB);
            PG8_BAR; PG8_WAIT_L(0); PG8_MMA(0, 1, At, B1); PG8_BAR;
            PG8_LDA(At, 1, 1); PG8_STAGE(PG8_SA(1, 0), a3, voffA);
            PG8_BAR; PG8_WAIT_L(0); PG8_MMA(1, 0, At, B0); PG8_BAR; PG8_SCHED;
            PG8_STAGE(PG8_SB(1, 1), b3 + hstep, voffB);
            PG8_WAIT_V(6); PG8_BAR; PG8_MMA(1, 1, At, B1); PG8_BAR;
            }
        }
        if constexpr (ALIGN_EPI) { if (wr == 0) PG8_BAR; }
        E(acc, cur, wr, wc, fr, fq);
        if (!has_next) break;
#pragma unroll
        for (int a = 0; a < 2; ++a)
#pragma unroll
            for (int b = 0; b < 2; ++b)
#pragma unroll
                for (int m = 0; m < 4; ++m)
#pragma unroll
                    for (int n = 0; n < 2; ++n) acc[a][b][m][n] = (f32x4){0.f, 0.f, 0.f, 0.f};
        cur = nxt; cA = nA; cB = nB; ++ui;
        if constexpr (ALIGN_EPI) { if (wr == 1) PG8_BAR; }
    }
    PG8_WAIT_V(0);
    if constexpr (!ALIGN_EPI) { if (wr == 0) PG8_BAR; }
    PG8_BAR;
#undef PG8_SA
#undef PG8_SB
#undef PG8_STAGE
#undef PG8_LDA
#undef PG8_LDB
#undef PG8_MMA
#undef PG8_WAIT_V
#undef PG8_WAIT_L
#undef PG8_BAR
#undef PG8_SCHED
}
}
using pg8::Unit;

typedef f32x4 Acc[2][2][4][2];

struct EpiInProj {
    static constexpr bool PERM = true;
    bf16_t *q, *k, *v, *g, *f; const float* ropec; const float* ropes;
    __device__ __forceinline__ void operator()(const Acc& acc, const Unit& u, int wr, int wc, int fr, int fq) const {
        const int pn = u.pn; bf16_t* base; int ldc, colt;
        if (pn < 2) { base = q; ldc = 512; colt = pn * 256; }
        else if (pn < 4) { base = k; ldc = 512; colt = (pn - 2) * 256; }
        else if (pn < 8) { base = v; ldc = 1024; colt = (pn - 4) * 256; }
        else if (pn < 12) { base = g; ldc = 1024; colt = (pn - 8) * 256; }
        else { base = f; ldc = 1024; colt = (pn - 12) * 256; }
        const bool rope = pn < 4;
        const int row0 = u.pm * 256 + wr * 64 + fr, col0 = colt + wc * 32 + 8 * fq;
#pragma unroll
        for (int ai = 0; ai < 2; ++ai)
#pragma unroll
            for (int m = 0; m < 4; ++m) {
                const int row = row0 + ai * 128 + m * 16;
                f32x4 cs = (f32x4){1.f, 1.f, 1.f, 1.f}, sn = (f32x4){0.f, 0.f, 0.f, 0.f};
                if (rope) { const int l = row & (SEQ - 1); const int p = (wc & 1) ? (l & 63) : (l >> 6); cs = *(const f32x4*)(ropec + p * 16 + 4 * fq); sn = *(const f32x4*)(ropes + p * 16 + 4 * fq); }
                bf16_t* rowp = base + (size_t)row * ldc + col0;
#pragma unroll
                for (int bj = 0; bj < 2; ++bj) {
                    const f32x4 t1 = acc[ai][bj][m][0], t2 = acc[ai][bj][m][1];
                    const f32x4 o1 = t1 * cs - t2 * sn, o2 = t1 * sn + t2 * cs;
                    u32x4 o; o.x = cvt_pk_bf16(o1[0], o1[1]); o.y = cvt_pk_bf16(o1[2], o1[3]); o.z = cvt_pk_bf16(o2[0], o2[1]); o.w = cvt_pk_bf16(o2[2], o2[3]);
                    *(u32x4*)(rowp + bj * 128) = o;
                }
            }
    }
};

struct EpiBf16 {
    static constexpr bool PERM = true;
    bf16_t* O; int ldc;
    __device__ __forceinline__ void operator()(const Acc& acc, const Unit& u, int wr, int wc, int fr, int fq) const {
        const int row0 = u.pm * 256 + wr * 64 + fr, col0 = u.pn * 256 + wc * 32 + 8 * fq;
#pragma unroll
        for (int ai = 0; ai < 2; ++ai)
#pragma unroll
            for (int m = 0; m < 4; ++m) {
                bf16_t* rowp = O + (size_t)(row0 + ai * 128 + m * 16) * ldc + col0;
#pragma unroll
                for (int bj = 0; bj < 2; ++bj) {
                    const f32x4 v0 = acc[ai][bj][m][0], v1 = acc[ai][bj][m][1];
                    u32x4 o; o.x = cvt_pk_bf16(v0[0], v0[1]); o.y = cvt_pk_bf16(v0[2], v0[3]); o.z = cvt_pk_bf16(v1[0], v1[1]); o.w = cvt_pk_bf16(v1[2], v1[3]);
                    *(u32x4*)(rowp + bj * 128) = o;
                }
            }
    }
};

struct EpiMerge {
    static constexpr bool PERM = true;
    const bf16_t* retd; const bf16_t* fourd; const float* bbg; bf16_t* merged;
    __device__ __forceinline__ void operator()(const Acc& acc, const Unit& u, int wr, int wc, int fr, int fq) const {
        const int row0 = u.pm * 256 + wr * 64 + fr, ch0 = u.pn * 128 + wc * 16 + 4 * fq;
        f32x4 br[2], bf[2];
#pragma unroll
        for (int bj = 0; bj < 2; ++bj) { br[bj] = *(const f32x4*)(bbg + ch0 + 64 * bj); bf[bj] = *(const f32x4*)(bbg + D + ch0 + 64 * bj); }
#pragma unroll
        for (int ai = 0; ai < 2; ++ai)
#pragma unroll
            for (int m = 0; m < 4; ++m) {
                const size_t ro = (size_t)(row0 + ai * 128 + m * 16) * D + ch0;
#pragma unroll
                for (int bj = 0; bj < 2; ++bj) {
                    const f32x4 a = acc[ai][bj][m][0] + br[bj], b = acc[ai][bj][m][1] + bf[bj];
                    const u32x2 rd = *(const u32x2*)(retd + ro + 64 * bj), fd = *(const u32x2*)(fourd + ro + 64 * bj);
                    const float o0 = sigmoidf_(a[0]) * bf_lo(rd.x) + sigmoidf_(b[0]) * bf_lo(fd.x);
                    const float o1 = sigmoidf_(a[1]) * bf_hi(rd.x) + sigmoidf_(b[1]) * bf_hi(fd.x);
                    const float o2 = sigmoidf_(a[2]) * bf_lo(rd.y) + sigmoidf_(b[2]) * bf_lo(fd.y);
                    const float o3 = sigmoidf_(a[3]) * bf_hi(rd.y) + sigmoidf_(b[3]) * bf_hi(fd.y);
                    u32x2 o; o.x = cvt_pk_bf16(o0, o1); o.y = cvt_pk_bf16(o2, o3);
                    *(u32x2*)(merged + ro + 64 * bj) = o;
                }
            }
    }
};

template <bool XIN_BF, bool OUT_BF> struct EpiResidT {
    static constexpr bool PERM = false;
    const void* xin; const float* gate; void* out;
    __device__ __forceinline__ void operator()(const Acc& acc, const Unit& u, int wr, int wc, int fr, int fq) const {
        const int row0 = u.pm * 256 + wr * 64 + fr, col0 = u.pn * 256 + wc * 32 + 4 * fq;
        const int b = (u.pm * 256) >> 13;
        f32x4 gv[2][2];
#pragma unroll
        for (int bj = 0; bj < 2; ++bj)
#pragma unroll
            for (int n = 0; n < 2; ++n) gv[bj][n] = *(const f32x4*)(gate + b * 6144 + col0 + bj * 128 + n * 16);
#pragma unroll
        for (int ai = 0; ai < 2; ++ai)
#pragma unroll
            for (int m = 0; m < 4; ++m) {
                const size_t ro = (size_t)(row0 + ai * 128 + m * 16) * D + col0;
#pragma unroll
                for (int bj = 0; bj < 2; ++bj)
#pragma unroll
                    for (int n = 0; n < 2; ++n) {
                        const size_t o_ = ro + bj * 128 + n * 16;
                        f32x4 xv;
                        if constexpr (XIN_BF) { const u32x2 q = *(const u32x2*)((const bf16_t*)xin + o_); xv = (f32x4){bf_lo(q.x), bf_hi(q.x), bf_lo(q.y), bf_hi(q.y)}; }
                        else xv = *(const f32x4*)((const float*)xin + o_);
                        const f32x4 r = xv + gv[bj][n] * acc[ai][bj][m][n];
                        if constexpr (OUT_BF) { u32x2 w; w.x = cvt_pk_bf16(r[0], r[1]); w.y = cvt_pk_bf16(r[2], r[3]); *(u32x2*)((bf16_t*)out + o_) = w; }
                        else *(f32x4*)((float*)out + o_) = r;
                    }
            }
    }
};
typedef EpiResidT<false, false> EpiResid;

struct EpiUpConv {
    static constexpr bool PERM = true;
    const float* convw; const float* convb; bf16_t* act; LAS float* wl;
    __device__ __forceinline__ void operator()(const Acc& acc, const Unit& u, int wr, int wc, int, int) const {
        const int ln_ = lane_id(), fr = ln_ & 15, fq = ln_ >> 4;
        const int b = u.pm / CONV_UNITS_PER_BATCH, up = u.pm % CONV_UNITS_PER_BATCH;
        const int ch0 = u.pn * 128 + wc * 32 + 8 * fq;
        if (wr == 0) { const int te = wc * 64 + (fq * 16 + fr), src = (te >> 7) * FFN + u.pn * 128 + (te & 127);
            wl[te] = convw[src]; wl[256 + te] = convw[NUP + src]; wl[512 + te] = convw[2 * NUP + src]; wl[768 + te] = convb[src]; }
        asm volatile("s_waitcnt lgkmcnt(0)" ::: "memory");
        __builtin_amdgcn_s_barrier();
        asm volatile("" ::: "memory");
#pragma unroll
        for (int n = 0; n < 2; ++n) {
            const int ch = ch0 + 4 * n;
#pragma unroll
            for (int ai = 0; ai < 2; ++ai) {
                const int j = 4 * up + 2 * ai + wr;
                const int t0 = 62 * j - 1 + fr;
                f32x4 ua[4];
#ifdef DBG_RAWUP
                f32x4 dbg_xp[4], dbg_xn[4];
#endif
                __builtin_amdgcn_sched_barrier(0);
#pragma unroll
                for (int part = 0; part < 2; ++part) {
                    __builtin_amdgcn_sched_barrier(0);
                    const LAS float* cw = wl + part * 128 + wc * 32 + 8 * fq + 4 * n;
                    const f32x4 w0 = *(const LAS f32x4*)(cw), w1 = *(const LAS f32x4*)(cw + 256), w2 = *(const LAS f32x4*)(cw + 512), bb = *(const LAS f32x4*)(cw + 768);
                    f32x4 xv[4];
#pragma unroll
                    for (int m = 0; m < 4; ++m) { const int t = t0 + 16 * m; const bool ok = (t >= 0) && (t < SEQ); xv[m] = ok ? acc[ai][part][m][n] : (f32x4){0.f, 0.f, 0.f, 0.f}; }
                    f32x4 x1[4];
#pragma unroll
                    for (int m = 0; m < 4; ++m)
#pragma unroll
                        for (int e = 0; e < 4; ++e) {
                            const float prv = xv[m > 0 ? m - 1 : 0][e], cur = xv[m][e];
                            const int e0 = __builtin_amdgcn_update_dpp(0, __float_as_int(prv), 0x10f, 0xf, 0xf, false);
                            x1[m][e] = __int_as_float(__builtin_amdgcn_update_dpp(e0, __float_as_int(cur), 0x111, 0xf, 0xf, false));
                        }
#pragma unroll
                    for (int m = 0; m < 4; ++m) {
                        f32x4 x2;
#pragma unroll
                        for (int e = 0; e < 4; ++e) {
                            const float prv = x1[m > 0 ? m - 1 : 0][e], cur = x1[m][e];
                            const int e0 = __builtin_amdgcn_update_dpp(0, __float_as_int(prv), 0x10f, 0xf, 0xf, false);
                            x2[e] = __int_as_float(__builtin_amdgcn_update_dpp(e0, __float_as_int(cur), 0x111, 0xf, 0xf, false));
                        }
                        const f32x4 uu = w0 * x2 + w1 * x1[m] + w2 * xv[m] + bb;
#ifdef DBG_RAWUP
                        if (part == 0) { dbg_xp[m] = x1[m]; dbg_xn[m] = x2; }
#endif
                        if (part == 0) ua[m] = uu;
                        else {
                            const int r = 16 * m + fr, t = t0 + 16 * m - 1;
                            if (r >= 2 && t < SEQ) {
                                u32x2 o; o.x = cvt_pk_bf16(gelu_tanh(ua[m][0]) * uu[0], gelu_tanh(ua[m][1]) * uu[1]); o.y = cvt_pk_bf16(gelu_tanh(ua[m][2]) * uu[2], gelu_tanh(ua[m][3]) * uu[3]);
#ifdef DBG_RAWUP
                                { o.x = cvt_pk_bf16(dbg_xp[m][0], dbg_xp[m][1]); o.y = cvt_pk_bf16(dbg_xn[m][2], dbg_xn[m][3]); }
#endif
                                *at_off<u32x2>(act, 2u * (unsigned)((b * SEQ + t) * FFN + ch)) = o;
                            }
                        }
                    }
                }
            }
        }
    }
};

struct Params {
    const float *x, *c, *ctx, *c_ctx, *w_mod, *b_mod, *norm1_w, *w_in, *dec_f, *dec_b, *w_ro, *w_fo, *w_bg, *b_bg, *w_out, *norm2_w, *w_up, *conv_w, *conv_b, *w_down, *fnorm_w;
    float* out; unsigned char* ws;
    int ph_lo, ph_hi;
};

template <int MAP> __device__ __forceinline__ int dst_row(int n) {
    if constexpr (MAP == 1) {
        if (n < 1024) { const int hd = n & ~63, d = n & 63, part = d >> 5, i = d & 31; return hd + (i >> 2) * 8 + part * 4 + (i & 3); }
        return n;
    } else if constexpr (MAP == 2) {
        const int br = n >> 10, ch = n & 1023; return (ch >> 2) * 8 + br * 4 + (ch & 3);
    } else if constexpr (MAP == 3) {
        const int part = n >= FFN ? 1 : 0, ch = n - part * FFN; return (ch >> 7) * 256 + part * 128 + (ch & 127);
    } else return n;
}
template <int MAP> __device__ __forceinline__ void transpose_item(const float* W, int K, int ldn, int nblk, bf16_t* WT, LAS float* scr, int item, int lane) {
    const int kb = item / nblk, nb = item % nblk, k0 = 64 * kb, n0 = 32 * nb;
#pragma unroll 8
    for (int i = 0; i < 32; ++i) { const int kk = 2 * i + (lane >> 5); scr[kk * 33 + (lane & 31)] = ld_nt(W + (size_t)(k0 + kk) * ldn + n0 + (lane & 31)); }
    asm volatile("s_waitcnt lgkmcnt(0)" ::: "memory");
    const int c = lane & 7;
#pragma unroll
    for (int j = 0; j < 4; ++j) { const int n = (lane >> 3) + 8 * j; const LAS float* s = scr + (8 * c) * 33 + n;
        const float sc = (MAP == 1 && (n0 + n) < 512) ? 0.125f : 1.f;
        u32x4 o; o.x = cvt_pk_bf16(s[0 * 33] * sc, s[1 * 33] * sc); o.y = cvt_pk_bf16(s[2 * 33] * sc, s[3 * 33] * sc); o.z = cvt_pk_bf16(s[4 * 33] * sc, s[5 * 33] * sc); o.w = cvt_pk_bf16(s[6 * 33] * sc, s[7 * 33] * sc);
        *(u32x4*)(WT + (size_t)dst_row<MAP>(n0 + n) * K + k0 + 8 * c) = o; }
    asm volatile("s_waitcnt lgkmcnt(0)" ::: "memory");
}

__device__ __forceinline__ void phase_prep(const Params& p, LAS unsigned char* lds, const int wv) {
    const int lane = lane_id(), wave = wv, tid = wv * 64 + lane;
    const int gw = blockIdx.x * 8 + wave, NGW = gridDim.x * 8;
    unsigned char* ws = p.ws;
    {
        const int gt = blockIdx.x * 512 + tid;
        if (gt < 2048) { const int pp = gt >> 4, f = gt & 15; const float inv = exp2f(-(float)f * (13.287712379549449f / 16.f)); const float ang = (float)pp * inv;
            float rev = ang * 0.15915494309189535f; rev -= floorf(rev);
            ((float*)(ws + WS_ROPEC))[gt] = cospif(2.f * rev); ((float*)(ws + WS_ROPES))[gt] = sinpif(2.f * rev); }
        if (gt < 8192) ((float*)(ws + WS_T8192))[gt] = cospif((float)gt * (1.f / 4096.f));
    }
    {
        LAS float* scr = (LAS float*)(lds + wave * 16384);
        constexpr int I1 = 16 * 96, I2 = 16 * 32, I3 = 8 * 32, I4 = 16 * 64, I5 = 16 * 32, I6 = 16 * 176, I7 = 44 * 32;
        constexpr int NIT = I1 + I2 + I3 + I4 + I5 + I6 + I7;
        for (int it = gw; it < NIT; it += NGW) {
            int r = it;
            if (r < I1) { transpose_item<1>(p.w_in, 1024, INC, 96, (bf16_t*)(ws + WS_WIN), scr, r, lane); continue; } r -= I1;
            if (r < I2) { transpose_item<0>(p.w_ro, 1024, 1024, 32, (bf16_t*)(ws + WS_WRO), scr, r, lane); continue; } r -= I2;
            if (r < I3) { transpose_item<0>(p.w_fo, 512, 1024, 32, (bf16_t*)(ws + WS_WFO), scr, r, lane); continue; } r -= I3;
            if (r < I4) { transpose_item<2>(p.w_bg, 1024, 2048, 64, (bf16_t*)(ws + WS_WBG), scr, r, lane); continue; } r -= I4;
            if (r < I5) { transpose_item<0>(p.w_out, 1024, 1024, 32, (bf16_t*)(ws + WS_WOUT), scr, r, lane); continue; } r -= I5;
            if (r < I6) { transpose_item<3>(p.w_up, 1024, NUP, 176, (bf16_t*)(ws + WS_WUP), scr, r, lane); continue; } r -= I6;
            transpose_item<0>(p.w_down, FFN, 1024, 32, (bf16_t*)(ws + WS_WDN), scr, r, lane);
        }
    }
    __syncthreads();
    {
        LAS float* wt = (LAS float*)lds;
        LAS float* tab = (LAS float*)(lds + 32 * 129 * 4);
        if (tid < 128) tab[tid] = cospif((float)tid * (1.f / 64.f));
        bf16_t* WT = (bf16_t*)(ws + WS_WIN);
        for (int it = blockIdx.x; it < 256; it += gridDim.x) {
            const int kb = it >> 3, g = (it >> 1) & 3, hf = it & 1;
            __syncthreads();
#pragma unroll
            for (int i = 0; i < 8; ++i) { const int idx = tid + 512 * i, kk = idx >> 7, cc = idx & 127; wt[kk * 129 + cc] = p.w_in[(size_t)(kb * 32 + kk) * INC + 3072 + g * 128 + cc]; }
            __syncthreads();
            const int k = tid & 31, cg4 = tid >> 5, cp0 = hf * 64 + cg4 * 4;
            float aC[4] = {0.f, 0.f, 0.f, 0.f}, aS[4] = {0.f, 0.f, 0.f, 0.f};
            float cr[4], sr[4], ct[4], st[4];
#pragma unroll
            for (int e = 0; e < 4; ++e) { cr[e] = 1.f; sr[e] = 0.f; ct[e] = cospif((float)(cp0 + e) * (1.f / 64.f)); st[e] = sinpif((float)(cp0 + e) * (1.f / 64.f)); }
            for (int cc = 0; cc < 128; ++cc) {
                const float w = wt[k * 129 + cc];
#pragma unroll
                for (int e = 0; e < 4; ++e) { aC[e] += w * cr[e]; aS[e] += w * sr[e]; const float nc = cr[e] * ct[e] - sr[e] * st[e], ns = sr[e] * ct[e] + cr[e] * st[e]; cr[e] = nc; sr[e] = ns; }
            }
#pragma unroll
            for (int e = 0; e < 4; ++e) {
                const int n = g * 128 + cp0 + e;
                WT[(size_t)(3072 + n) * 1024 + kb * 32 + k] = (bf16_t)(cvt_pk_bf16(aC[e] * 0.0625f, 0.f) & 0xffffu);
                WT[(size_t)(3584 + n) * 1024 + kb * 32 + k] = (bf16_t)(cvt_pk_bf16(-aS[e] * 0.0625f, 0.f) & 0xffffu);
            }
        }
        __syncthreads();
    }
    {
        LAS float* sl = (LAS float*)lds;
        LAS float* red = (LAS float*)(lds + 16384);
        if (blockIdx.x < 96) {
#pragma unroll
            for (int i = 0; i < 6; ++i) { const int idx = tid + 512 * i; sl[idx] = siluf_(idx < 2048 ? p.c[idx] : p.c_ctx[idx - 2048]); }
        }
        __syncthreads();
        for (int it = blockIdx.x; it < 96; it += gridDim.x) {
            const int col = it * 64 + lane;
            float a0 = 0.f, a1 = 0.f, a2 = 0.f;
            const float* wp = p.w_mod + (size_t)(wave * 128) * 6144 + col;
#pragma unroll 16
            for (int kk = 0; kk < 128; ++kk) {
                const float wv = ld_nt(wp + (size_t)kk * 6144); const int k = wave * 128 + kk;
                a0 += sl[k] * wv; a1 += sl[1024 + k] * wv; a2 += sl[2048 + k] * wv;
            }
            __syncthreads();
            red[(wave * 3 + 0) * 64 + lane] = a0; red[(wave * 3 + 1) * 64 + lane] = a1; red[(wave * 3 + 2) * 64 + lane] = a2;
            __syncthreads();
            if (wave < 3) { float sres = p.b_mod[col];
#pragma unroll
                for (int w = 0; w < 8; ++w) sres += red[(w * 3 + wave) * 64 + lane];
                ((float*)(ws + WS_MODV))[wave * 6144 + col] = sres; }
        }
        __syncthreads();
    }
}

template <int MODE> __device__ __forceinline__ void norm_row(const float* xrow, const float* w, const float* sc, const float* sh, void* orow, int lane) {
    const f32x4* xr = (const f32x4*)xrow + lane;
    f32x4 v[4]; float s = 0.f;
#pragma unroll
    for (int j = 0; j < 4; ++j) { v[j] = xr[64 * j]; s += (v[j][0] * v[j][0] + v[j][1] * v[j][1]) + (v[j][2] * v[j][2] + v[j][3] * v[j][3]); }
    const float rs = rsqrtf(wave_sum(s) * (1.f / D) + EPS);
#pragma unroll
    for (int j = 0; j < 4; ++j) {
        const int c = 4 * lane + 256 * j;
        f32x4 y = v[j] * rs * *(const f32x4*)(w + c);
        if constexpr (MODE == 0) {
            y = y * (*(const f32x4*)(sc + c) + 1.f) + *(const f32x4*)(sh + c);
            u32x2 o; o.x = cvt_pk_bf16(y[0], y[1]); o.y = cvt_pk_bf16(y[2], y[3]);
            *(u32x2*)((bf16_t*)orow + c) = o;
        } else {
#ifdef NAN_PROBE
#pragma unroll
            for (int e = 0; e < 4; ++e) if (!(fabsf(y[e]) < 1e30f)) y[e] = 1000.f;
#endif
            *(f32x4*)((float*)orow + c) = y; }
    }
}

template <int MODE> __device__ __forceinline__ void norm_row2(const float* x0, const float* x1, const float* w, const float* sc0, const float* sh0, const float* sc1, const float* sh1, void* o0, void* o1, bool rvalid1, int lane) {
    const f32x4* xr0 = (const f32x4*)x0 + lane; const f32x4* xr1 = (const f32x4*)(rvalid1 ? x1 : x0) + lane;
    f32x4 v0[4], v1[4]; float s0 = 0.f, s1 = 0.f;
#pragma unroll
    for (int j = 0; j < 4; ++j) { v0[j] = ld_nt(xr0 + 64 * j); v1[j] = ld_nt(xr1 + 64 * j); }
#pragma unroll
    for (int j = 0; j < 4; ++j) { s0 += (v0[j][0] * v0[j][0] + v0[j][1] * v0[j][1]) + (v0[j][2] * v0[j][2] + v0[j][3] * v0[j][3]); s1 += (v1[j][0] * v1[j][0] + v1[j][1] * v1[j][1]) + (v1[j][2] * v1[j][2] + v1[j][3] * v1[j][3]); }
#pragma unroll
    for (int o = 1; o < 64; o <<= 1) { s0 += __shfl_xor(s0, o); s1 += __shfl_xor(s1, o); }
    const float rs0 = rsqrtf(s0 * (1.f / D) + EPS), rs1 = rsqrtf(s1 * (1.f / D) + EPS);
#pragma unroll
    for (int j = 0; j < 4; ++j) {
        const int c = 4 * lane + 256 * j; const f32x4 wv = *(const f32x4*)(w + c);
        f32x4 y0 = v0[j] * rs0 * wv, y1 = v1[j] * rs1 * wv;
        if constexpr (MODE == 0) {
            y0 = y0 * (*(const f32x4*)(sc0 + c) + 1.f) + *(const f32x4*)(sh0 + c); y1 = y1 * (*(const f32x4*)(sc1 + c) + 1.f) + *(const f32x4*)(sh1 + c);
            u32x2 a; a.x = cvt_pk_bf16(y0[0], y0[1]); a.y = cvt_pk_bf16(y0[2], y0[3]); *(u32x2*)((bf16_t*)o0 + c) = a;
            if (rvalid1) { u32x2 bq; bq.x = cvt_pk_bf16(y1[0], y1[1]); bq.y = cvt_pk_bf16(y1[2], y1[3]); *(u32x2*)((bf16_t*)o1 + c) = bq; }
        } else { *(f32x4*)((float*)o0 + c) = y0; if (rvalid1) *(f32x4*)((float*)o1 + c) = y1; }
    }
}

__device__ __forceinline__ bf16x8 tr_frag(LAS unsigned char* tile, int rs, int row0, int col0, int lane) {
    const int g = lane >> 4, q = (lane & 15) >> 2, pp = lane & 3;
    LAS unsigned char* a = tile + (row0 + 8 * g + q) * rs + (col0 + 4 * pp) * 2;
    const s16x4 lo = __builtin_amdgcn_ds_read_tr16_b64_v4i16((LAS s16x4*)a);
    const s16x4 hi = __builtin_amdgcn_ds_read_tr16_b64_v4i16((LAS s16x4*)(a + 4 * rs));
    return __builtin_shufflevector(lo, hi, 0, 1, 2, 3, 4, 5, 6, 7);
}
__device__ __forceinline__ bf16x8 row_frag(LAS unsigned char* tile, int rs, int row0, int col0, int lane) {
    return *(const LAS bf16x8*)(tile + (row0 + (lane & 15)) * rs + (col0 + 8 * (lane >> 4)) * 2);
}
__device__ __forceinline__ bf16x8 scale_frag(bf16x8 v, float s) {
    const u32x4 u = __builtin_bit_cast(u32x4, v); u32x4 o;
    o.x = cvt_pk_bf16(bf_lo(u.x) * s, bf_hi(u.x) * s); o.y = cvt_pk_bf16(bf_lo(u.y) * s, bf_hi(u.y) * s);
    o.z = cvt_pk_bf16(bf_lo(u.z) * s, bf_hi(u.z) * s); o.w = cvt_pk_bf16(bf_lo(u.w) * s, bf_hi(u.w) * s);
    return __builtin_bit_cast(bf16x8, o);
}
template <int ROWS, int COLS> __device__ __forceinline__ void stage_load(u32x4 (&v)[ROWS * COLS / 8 / 512], const bf16_t* src, size_t gld, int tid) {
    constexpr int CPR = COLS / 8, N = ROWS * CPR / 512;
#pragma unroll
    for (int i = 0; i < N; ++i) { const int id = tid + 512 * i, r = id / CPR, c = id % CPR; v[i] = *(const u32x4*)(src + (size_t)r * gld + c * 8); }
}
template <int ROWS, int COLS> __device__ __forceinline__ void stage_store(LAS unsigned char* dst, int rs, const u32x4 (&v)[ROWS * COLS / 8 / 512], int tid) {
    constexpr int CPR = COLS / 8, N = ROWS * CPR / 512;
#pragma unroll
    for (int i = 0; i < N; ++i) { const int id = tid + 512 * i, r = id / CPR, c = id % CPR; *(LAS u32x4*)(dst + r * rs + c * 16) = v[i]; }
}
template <int ROWS, int COLS> __device__ __forceinline__ void stage_tile(LAS unsigned char* dst, int rs, const bf16_t* src, size_t gld, int tid) {
    static_assert((ROWS * COLS / 8) % 512 == 0, "tile pieces must divide over 512 threads");
    u32x4 v[ROWS * COLS / 8 / 512];
    stage_load<ROWS, COLS>(v, src, gld, tid); stage_store<ROWS, COLS>(dst, rs, v, tid);
}

constexpr int RSK = 144, RSV = 272;

__device__ __forceinline__ void phase_kvinc(const Params& p, LAS unsigned char* lds, const int wv, const int it_lo, const int it_hi, const int it_step) {
    const int lane = lane_id(), wave = wv, tid = wv * 64 + lane;
    const bf16_t* kb = (const bf16_t*)(p.ws + WS_K); const bf16_t* vb = (const bf16_t*)(p.ws + WS_V);
    bf16_t* kvinc = (bf16_t*)((unsigned char*)p.out + DO_KVINC);
    LAS unsigned char* Kf = lds; LAS unsigned char* Kb = lds + 128 * RSK; LAS unsigned char* Vt = lds + 2 * 128 * RSK;
    for (int it = it_lo; it < it_hi; it += it_step) {
        const int bh = it >> 6, n = it & 63, b = bh >> 3, h = bh & 7;
        const size_t tok0 = (size_t)b * SEQ + (size_t)n * CH;
        const float lgf = -__expf(p.dec_f[h]) * 1.4426950408889634f, lgb = -__expf(p.dec_b[h]) * 1.4426950408889634f;
        __syncthreads();
#pragma unroll
        for (int i = 0; i < 2; ++i) { const int id = tid + 512 * i, r = id >> 3, c = id & 7;
            const bf16x8 kv = *(const bf16x8*)(kb + (tok0 + r) * 512 + h * 64 + c * 8);
            *(LAS bf16x8*)(Kf + r * RSK + c * 16) = scale_frag(kv, exp2f(lgf * (float)(127 - r)));
            *(LAS bf16x8*)(Kb + r * RSK + c * 16) = scale_frag(kv, exp2f(lgb * (float)r)); }
        stage_tile<128, 128>(Vt, RSV, vb + tok0 * 1024 + h * 128, 1024, tid);
        __syncthreads();
        const int dir = wave >> 2, nt0 = 2 * (wave & 3);
        LAS unsigned char* Kd = dir ? Kb : Kf;
        f32x4 acc[4][2];
#pragma unroll
        for (int m = 0; m < 4; ++m) { acc[m][0] = (f32x4){0.f, 0.f, 0.f, 0.f}; acc[m][1] = (f32x4){0.f, 0.f, 0.f, 0.f}; }
#pragma unroll
        for (int ks = 0; ks < 4; ++ks) {
            const bf16x8 b0 = tr_frag(Vt, RSV, 32 * ks, 16 * nt0, lane), b1 = tr_frag(Vt, RSV, 32 * ks, 16 * nt0 + 16, lane);
#pragma unroll
            for (int m = 0; m < 4; ++m) { const bf16x8 a = tr_frag(Kd, RSK, 32 * ks, 16 * m, lane);
                acc[m][0] = __builtin_amdgcn_mfma_f32_16x16x32_bf16(a, b0, acc[m][0], 0, 0, 0);
                acc[m][1] = __builtin_amdgcn_mfma_f32_16x16x32_bf16(a, b1, acc[m][1], 0, 0, 0); }
        }
        bf16_t* o = kvinc + ((size_t)it * 2 + dir) * 8192;
#pragma unroll
        for (int m = 0; m < 4; ++m)
#pragma unroll
            for (int j = 0; j < 2; ++j) { const int dv = 16 * (nt0 + j) + (lane & 15), dk = 16 * m + 4 * (lane >> 4);
                u32x2 w; w.x = cvt_pk_bf16(acc[m][j][0], acc[m][j][1]); w.y = cvt_pk_bf16(acc[m][j][2], acc[m][j][3]);
                *(u32x2*)(o + dv * 64 + dk) = w; }
    }
}

__device__ __forceinline__ void phase_scan(const Params& p, const int wv) {
    const int tid = wv * 64 + lane_id();
    const bf16_t* kvc = (const bf16_t*)(p.ws + WS_KVC);
    const bf16_t* kvinc = (const bf16_t*)((unsigned char*)p.out + DO_KVINC);
    bf16_t* sprev = (bf16_t*)(p.ws + WS_SPREV);
    for (int it = blockIdx.x; it < 256; it += gridDim.x) {
        const int bh = it >> 4, dir = (it >> 3) & 1, sl = it & 7, b = bh >> 3, h = bh & 7;
        const int dv = 16 * sl + (tid >> 5), dk = 2 * (tid & 31);
        const float a = dir ? p.dec_b[h] : p.dec_f[h];
        const float lg = -__expf(a), gam = __expf(lg), gamC = __expf(lg * (float)CH);
        float s0 = 0.f, s1 = 0.f;
#pragma unroll 32
        for (int jj = 0; jj < CTX; ++jj) {
            const int j = dir ? (CTX - 1 - jj) : jj;
            const bf16_t* row = kvc + (size_t)(b * CTX + j) * 1536;
            const unsigned kk = *(const unsigned*)(row + h * 64 + dk); const float vv = bf2f(row[512 + h * 128 + dv]);
            s0 = gam * s0 + bf_lo(kk) * vv; s1 = gam * s1 + bf_hi(kk) * vv;
        }
#pragma unroll 16
        for (int nn = 0; nn < NCH; ++nn) {
            const int n = dir ? (NCH - 1 - nn) : nn;
            const size_t off = (((size_t)bh * NCH + n) * 2 + dir) * 8192 + dv * 64 + dk;
            const unsigned inc = *(const unsigned*)(kvinc + off);
            *(unsigned*)(sprev + off) = cvt_pk_bf16(s0, s1);
            s0 = gamC * s0 + bf_lo(inc); s1 = gamC * s1 + bf_hi(inc);
        }
    }
}

__device__ __forceinline__ void phase_retout(const Params& p, LAS unsigned char* lds, const int wv) {
    const int lane = lane_id(), wave = wv, tid = wv * 64 + lane;
    const bf16_t* qb = (const bf16_t*)(p.ws + WS_Q); const bf16_t* kb = (const bf16_t*)(p.ws + WS_K); const bf16_t* vb = (const bf16_t*)(p.ws + WS_V); const bf16_t* gb = (const bf16_t*)(p.ws + WS_G);
    const bf16_t* sprev = (const bf16_t*)(p.ws + WS_SPREV);
    bf16_t* R = (bf16_t*)((unsigned char*)p.out + DO_R);
    LAS unsigned char* Kt = lds; LAS unsigned char* Vt = Kt + 128 * RSK; LAS unsigned char* Sf = Vt + 128 * RSV; LAS unsigned char* Sb = Sf + 128 * RSK; LAS unsigned char* Pw = Sb + 128 * RSK + wave * (16 * RSV);
    u32x4 pk[2], pv[4], psf[2], psb[2]; bf16x8 pq0, pq1;
#define RET_PREFETCH(itx) do { const int bh_ = (itx) >> 6, n_ = (itx) & 63, b_ = bh_ >> 3, h_ = bh_ & 7; const size_t tk_ = (size_t)b_ * SEQ + (size_t)n_ * CH; \
        stage_load<128, 64>(pk, kb + tk_ * 512 + h_ * 64, 512, tid); stage_load<128, 128>(pv, vb + tk_ * 1024 + h_ * 128, 1024, tid); \
        stage_load<128, 64>(psf, sprev + ((size_t)(itx) * 2 + 0) * 8192, 64, tid); stage_load<128, 64>(psb, sprev + ((size_t)(itx) * 2 + 1) * 8192, 64, tid); \
        const bf16_t* qr_ = qb + (tk_ + 16 * wave + (lane & 15)) * 512 + h_ * 64 + 8 * (lane >> 4); pq0 = *(const bf16x8*)qr_; pq1 = *(const bf16x8*)(qr_ + 32); } while (0)
    if ((int)blockIdx.x < 1024) RET_PREFETCH((int)blockIdx.x);
    for (int it = blockIdx.x; it < 1024; it += gridDim.x) {
        const int bh = it >> 6, n = it & 63, b = bh >> 3, h = bh & 7;
        const size_t tok0 = (size_t)b * SEQ + (size_t)n * CH;
        const float lgf = -__expf(p.dec_f[h]) * 1.4426950408889634f, lgb = -__expf(p.dec_b[h]) * 1.4426950408889634f;
        __syncthreads();
        stage_store<128, 64>(Kt, RSK, pk, tid); stage_store<128, 128>(Vt, RSV, pv, tid); stage_store<128, 64>(Sf, RSK, psf, tid); stage_store<128, 64>(Sb, RSK, psb, tid);
        const int cl = 16 * wave + (lane & 15);
        const bf16x8 q0 = pq0, q1 = pq1;
        __syncthreads();
        { const int itn = (it + (int)gridDim.x < 1024) ? it + (int)gridDim.x : it; RET_PREFETCH(itn); }
#pragma unroll
        for (int mt = 0; mt < 8; ++mt) {
            f32x4 sc = (f32x4){0.f, 0.f, 0.f, 0.f};
            sc = __builtin_amdgcn_mfma_f32_16x16x32_bf16(row_frag(Kt, RSK, 16 * mt, 0, lane), q0, sc, 0, 0, 0);
            sc = __builtin_amdgcn_mfma_f32_16x16x32_bf16(row_frag(Kt, RSK, 16 * mt, 32, lane), q1, sc, 0, 0, 0);
            float w[4];
#pragma unroll
            for (int r = 0; r < 4; ++r) { const int s = 16 * mt + 4 * (lane >> 4) + r, d = cl - s;
                w[r] = sc[r] * (d > 0 ? exp2f(lgf * (float)d) : (d < 0 ? exp2f(lgb * (float)(-d)) : 2.f)); }
            u32x2 o; o.x = cvt_pk_bf16(w[0], w[1]); o.y = cvt_pk_bf16(w[2], w[3]);
            *(LAS u32x2*)(Pw + (lane & 15) * RSV + (16 * mt + 4 * (lane >> 4)) * 2) = o;
        }
        asm volatile("s_waitcnt lgkmcnt(0)" ::: "memory");
        f32x4 o[8];
#pragma unroll
        for (int mt = 0; mt < 8; ++mt) o[mt] = (f32x4){0.f, 0.f, 0.f, 0.f};
#pragma unroll
        for (int ks = 0; ks < 4; ++ks) {
            const bf16x8 pf = *(const LAS bf16x8*)(Pw + (lane & 15) * RSV + (32 * ks + 8 * (lane >> 4)) * 2);
#pragma unroll
            for (int mt = 0; mt < 8; ++mt) o[mt] = __builtin_amdgcn_mfma_f32_16x16x32_bf16(tr_frag(Vt, RSV, 32 * ks, 16 * mt, lane), pf, o[mt], 0, 0, 0);
        }
        {
            const float sf = exp2f(lgf * (float)(cl + 1)), sb = exp2f(lgb * (float)(CH - cl));
            const bf16x8 qf0 = scale_frag(q0, sf), qf1 = scale_frag(q1, sf), qb0 = scale_frag(q0, sb), qb1 = scale_frag(q1, sb);
#pragma unroll
            for (int mt = 0; mt < 8; ++mt) {
                o[mt] = __builtin_amdgcn_mfma_f32_16x16x32_bf16(row_frag(Sf, RSK, 16 * mt, 0, lane), qf0, o[mt], 0, 0, 0);
                o[mt] = __builtin_amdgcn_mfma_f32_16x16x32_bf16(row_frag(Sf, RSK, 16 * mt, 32, lane), qf1, o[mt], 0, 0, 0);
                o[mt] = __builtin_amdgcn_mfma_f32_16x16x32_bf16(row_frag(Sb, RSK, 16 * mt, 0, lane), qb0, o[mt], 0, 0, 0);
                o[mt] = __builtin_amdgcn_mfma_f32_16x16x32_bf16(row_frag(Sb, RSK, 16 * mt, 32, lane), qb1, o[mt], 0, 0, 0);
            }
        }
        float s = 0.f;
#pragma unroll
        for (int mt = 0; mt < 8; ++mt) s += (o[mt][0] + o[mt][1]) + (o[mt][2] + o[mt][3]);
        s += __shfl_xor(s, 16); s += __shfl_xor(s, 32);
        const float mu = s * (1.f / DV);
        float s2 = 0.f;
#pragma unroll
        for (int mt = 0; mt < 8; ++mt) { o[mt] = o[mt] - mu; s2 += (o[mt][0] * o[mt][0] + o[mt][1] * o[mt][1]) + (o[mt][2] * o[mt][2] + o[mt][3] * o[mt][3]); }
        s2 += __shfl_xor(s2, 16); s2 += __shfl_xor(s2, 32);
        const float rstd = rsqrtf(s2 * (1.f / DV) + EPS);
        const size_t ro = (tok0 + cl) * 1024 + h * 128 + 4 * (lane >> 4);
#pragma unroll
        for (int mt = 0; mt < 8; ++mt) {
            const u32x2 gg = *(const u32x2*)(gb + ro + 16 * mt);
            u32x2 w; w.x = cvt_pk_bf16(o[mt][0] * rstd * siluf_(bf_lo(gg.x)), o[mt][1] * rstd * siluf_(bf_hi(gg.x)));
            w.y = cvt_pk_bf16(o[mt][2] * rstd * siluf_(bf_lo(gg.y)), o[mt][3] * rstd * siluf_(bf_hi(gg.y)));
            *(u32x2*)(R + ro + 16 * mt) = w;
        }
    }
}

constexpr int RSX = 528;
template <int STAGE> __device__ __forceinline__ void phase_dft(const Params& p, LAS unsigned char* lds, const int wv, const int it_lo, const int it_hi, const int it_step) {
    const int lane = lane_id(), wave = wv, tid = wv * 64 + lane;
    const float* T = (const float*)(p.ws + WS_T8192);
    const bf16_t* fbuf = (const bf16_t*)(p.ws + WS_F);
    bf16_t* Y = (bf16_t*)((unsigned char*)p.out + DO_Y);
    bf16_t* Z = (bf16_t*)(p.ws + WS_Z);
    LAS unsigned char* Mt = lds; LAS unsigned char* Xt = lds + 128 * RSV;
    for (int it = it_lo; it < it_hi; it += it_step) {
        const int b = it >> 7;
        const int l2 = it & 127;
        const int l1p = (it >> 1) & 63, chalf = it & 1;
        f32x4 acc[2][8];
#pragma unroll
        for (int hh = 0; hh < 2; ++hh) {
            __syncthreads();
            if (STAGE == 0 ? (hh == 0) : true) {
#pragma unroll 8
                for (int id = tid; id < 128 * 128; id += 512) {
                    const int o = id >> 7, k = id & 127; float val;
                    if constexpr (STAGE == 0) {
                        const int rip = o >> 6, l1q = o & 63, ri = k >> 6, l1 = k & 63;
                        const int j = (l1q * (128 * l1 + l2)) & 8191;
                        const float cs = T[j], sn = T[(j + 6144) & 8191];
                        val = (rip == ri) ? cs : (rip == 0 ? sn : -sn);
                    } else {
                        const int j = (64 * ((o * k) & 127)) & 8191;
                        val = hh == 0 ? T[j] : T[(j + 6144) & 8191];
                    }
                    *(LAS bf16_t*)(Mt + o * RSV + k * 2) = (bf16_t)(cvt_pk_bf16(val * 0.125f, 0.f) & 0xffffu);
                }
            }
            {
                u32x4 xv[8];
#pragma unroll
                for (int i = 0; i < 8; ++i) { const int id = tid + 512 * i, k = id >> 5, c = id & 31;
                    if constexpr (STAGE == 0) { const int ri = k >> 6, l1 = k & 63; xv[i] = *(const u32x4*)(fbuf + ((size_t)b * SEQ + 128 * l1 + l2) * 1024 + ri * 512 + hh * 256 + c * 8); }
                    else xv[i] = *(const u32x4*)(Y + ((((size_t)b * 64 + l1p) * 2 + hh) * 128 + k) * 512 + chalf * 256 + c * 8); }
#pragma unroll
                for (int i = 0; i < 8; ++i) { const int id = tid + 512 * i, k = id >> 5, c = id & 31; *(LAS u32x4*)(Xt + k * RSX + c * 16) = xv[i]; }
            }
            __syncthreads();
            if (STAGE == 0 || hh == 0) {
#pragma unroll
                for (int i = 0; i < 2; ++i)
#pragma unroll
                    for (int nt = 0; nt < 8; ++nt) acc[i][nt] = (f32x4){0.f, 0.f, 0.f, 0.f};
            }
#pragma unroll
            for (int ks = 0; ks < 4; ++ks) {
                const bf16x8 a0 = tr_frag(Xt, RSX, 32 * ks, 32 * wave, lane), a1 = tr_frag(Xt, RSX, 32 * ks, 32 * wave + 16, lane);
#pragma unroll
                for (int nt = 0; nt < 8; ++nt) { const bf16x8 bm = row_frag(Mt, RSV, 16 * nt, 32 * ks, lane);
                    acc[0][nt] = __builtin_amdgcn_mfma_f32_16x16x32_bf16(a0, bm, acc[0][nt], 0, 0, 0);
                    acc[1][nt] = __builtin_amdgcn_mfma_f32_16x16x32_bf16(a1, bm, acc[1][nt], 0, 0, 0); }
            }
            if (STAGE == 0 || hh == 1) {
#pragma unroll
                for (int i = 0; i < 2; ++i)
#pragma unroll
                    for (int nt = 0; nt < 8; ++nt) {
                        const int o = 16 * nt + (lane & 15), chl = 32 * wave + 16 * i + 4 * (lane >> 4);
                        u32x2 w; w.x = cvt_pk_bf16(acc[i][nt][0], acc[i][nt][1]); w.y = cvt_pk_bf16(acc[i][nt][2], acc[i][nt][3]);
                        if constexpr (STAGE == 0) { const int rip = o >> 6, l1q = o & 63;
                            *(u32x2*)(Y + ((((size_t)b * 64 + l1q) * 2 + rip) * 128 + l2) * 512 + hh * 256 + chl) = w;
                        } else *(u32x2*)(Z + ((size_t)b * SEQ + l1p + 64 * o) * 512 + chalf * 256 + chl) = w;
                    }
            }
        }
    }
}

#define XB_TMO      128
#define XB_XCNT(j)  (256  + 64 * (j))
#define XB_XSUB(j)  (1280 + 64 * (j))
#define XB_XGEN(j)  (2304 + 64 * (j))
#define XB_TOP      3328
#define XB_TOPGEN   3392
#define XCD_BAR_WORDS 3456
#define XB_SPIN_CAP (1u << 18)
__device__ __forceinline__ unsigned xb_ld(unsigned* p)              { return __hip_atomic_load(p, __ATOMIC_RELAXED, __HIP_MEMORY_SCOPE_AGENT); }
__device__ __forceinline__ unsigned xb_add(unsigned* p, unsigned v) { return __hip_atomic_fetch_add(p, v, __ATOMIC_RELAXED, __HIP_MEMORY_SCOPE_AGENT); }
__device__ __forceinline__ unsigned xb_xcc_id() { return (unsigned)__builtin_amdgcn_s_getreg((3 << 11) | 20) & 0xFu; }
#define XB_SPIN(cond, bar) do { unsigned _sp = 0; while (cond) { __builtin_amdgcn_s_sleep(1); \
    if ((++_sp & 255u) == 0u) { if (xb_ld(&(bar)[XB_TMO])) break; if (_sp > XB_SPIN_CAP) { atomicAdd(&(bar)[XB_TMO], 1u); break; } } } } while (0)
struct XcdBarrier { unsigned* bar; unsigned x; volatile LAS unsigned* st; };
__device__ __forceinline__ XcdBarrier xcd_barrier_post(unsigned* bar, volatile LAS unsigned* st, bool t0) {
    XcdBarrier b; b.bar = bar; b.x = xb_xcc_id(); b.st = st;
    if (t0) (void)xb_add(&bar[XB_XCNT(b.x)], 1u);
    return b;
}
__device__ __forceinline__ void xcd_barrier_complete(unsigned* bar, unsigned x, unsigned& nloc, unsigned& nx) {
    const unsigned G = gridDim.x * gridDim.y * gridDim.z;
    unsigned sum, cnt, mine, sp = 0u;
    for (;;) {
        sum = 0u; cnt = 0u; mine = 0u;
#pragma unroll
        for (unsigned j = 0; j < 16; ++j) { const unsigned c = xb_ld(&bar[XB_XCNT(j)]); sum += c; cnt += (c > 0u) ? 1u : 0u; mine = (j == x) ? c : mine; }
        if (sum == G) break;
        __builtin_amdgcn_s_sleep(1);
        if ((++sp & 255u) == 0u) { if (xb_ld(&bar[XB_TMO])) break; if (sp > XB_SPIN_CAP) { atomicAdd(&bar[XB_TMO], 1u); break; } }
    }
    nloc = mine > 0u ? mine : 1u; nx = cnt > 0u ? cnt : 1u;
}
__device__ __forceinline__ void xcd_barrier(const XcdBarrier& b, bool t0) {
    asm volatile("s_waitcnt vmcnt(0)" ::: "memory");
    __syncthreads();
    if (t0) {
        unsigned* bar = b.bar;
        __builtin_amdgcn_s_waitcnt(0);
        unsigned nloc = b.st[0], nx = b.st[1];
        if (nloc == 0u) { xcd_barrier_complete(bar, b.x, nloc, nx); b.st[0] = nloc; b.st[1] = nx; }
        const unsigned old = xb_add(&bar[XB_XSUB(b.x)], 1u);
        const unsigned gen = old / nloc;
        if (old + 1u == (gen + 1u) * nloc) {
            __builtin_amdgcn_fence(__ATOMIC_RELEASE, "agent");
            asm volatile("s_waitcnt vmcnt(0)" ::: "memory");
            const unsigned og = xb_add(&bar[XB_TOP], 1u);
            const unsigned tg = og / nx;
            if (og + 1u == (tg + 1u) * nx) xb_add(&bar[XB_TOPGEN], 1u);
            else XB_SPIN(xb_ld(&bar[XB_TOPGEN]) == tg, bar);
            __builtin_amdgcn_fence(__ATOMIC_ACQUIRE, "agent");
            xb_add(&bar[XB_XGEN(b.x)], 1u);
            asm volatile("s_waitcnt vmcnt(0)" ::: "memory");
        } else {
            XB_SPIN(xb_ld(&bar[XB_XGEN(b.x)]) == gen, bar);
            __builtin_amdgcn_fence(__ATOMIC_ACQUIRE, "agent");
            asm volatile("s_waitcnt vmcnt(0)" ::: "memory");
        }
    }
    __syncthreads();
}

__global__ void __launch_bounds__(512, 2) mk_fwd(Params p) {
    extern __shared__ __attribute__((aligned(16))) unsigned char shm[];
    LAS unsigned char* lds = (LAS unsigned char*)shm;
    unsigned char* ws = p.ws;
    const int wv = __builtin_amdgcn_readfirstlane((int)threadIdx.x >> 6);
    const int wave = wv;
    const int gw = blockIdx.x * 8 + wave, NGW = gridDim.x * 8;
    const float* modv = (const float*)(ws + WS_MODV);
    pg8::StaticOrder S;
#if MK_MULTI
#define GRID_SYNC() do { } while (0)
#else
    cg::grid_group grid = cg::this_grid();
#define GRID_SYNC() do { asm volatile("s_waitcnt vmcnt(0) lgkmcnt(0)" ::: "memory"); grid.sync(); \
        __builtin_amdgcn_fence(__ATOMIC_ACQUIRE, "agent"); asm volatile("s_waitcnt vmcnt(0)" ::: "memory"); } while (0)
#endif
#ifndef PH_MASK
#define PH_MASK 0xffff
#endif
#define IN(k) (((PH_MASK >> (k)) & 1) && p.ph_lo <= (k) && (k) < p.ph_hi)
#if MK_MULTI
#define SEAM(k) do { } while (0)
#else
    const bool t0 = (wv == 0) && (lane_id() == 0);
    volatile LAS unsigned* xst = (volatile LAS unsigned*)(lds + 131072 + 512);
    if (t0) { xst[0] = 0u; xst[1] = 0u; }
    __syncthreads();
    const XcdBarrier XB = xcd_barrier_post((unsigned*)(ws + WS_XBAR), xst, t0);
#define SEAM(k) do { if (IN(k) && IN((k) + 1)) xcd_barrier(XB, t0); } while (0)
#endif

#if !MK_MULTI
    if (p.ph_hi < 0) GRID_SYNC();
#endif
    if (IN(0)) phase_prep(p, lds, wv);
    SEAM(0);
    if (IN(1)) {
        bf16_t* hb = (bf16_t*)(ws + WS_H);
        const int ln = lane_id();
        for (int r = gw; r < M + MC; r += 2 * NGW) {
            const int r1 = r + NGW; const bool v1 = r1 < M + MC; const int q1 = v1 ? r1 : r;
            const int i0 = r < M ? (r >> 13) : 2, i1 = q1 < M ? (q1 >> 13) : 2;
            const float* x0 = r < M ? p.x + (size_t)r * D : p.ctx + (size_t)(r - M) * D; const float* x1p = q1 < M ? p.x + (size_t)q1 * D : p.ctx + (size_t)(q1 - M) * D;
            norm_row2<0>(x0, x1p, p.norm1_w, modv + i0 * 6144 + 1024, modv + i0 * 6144, modv + i1 * 6144 + 1024, modv + i1 * 6144, hb + (size_t)r * D, hb + (size_t)q1 * D, v1, ln);
        }
    }
    SEAM(1);
    if (IN(2)) {
        EpiInProj E; E.q = (bf16_t*)(ws + WS_Q); E.k = (bf16_t*)(ws + WS_K); E.v = (bf16_t*)(ws + WS_V); E.g = (bf16_t*)(ws + WS_G); E.f = (bf16_t*)(ws + WS_F);
        E.ropec = (const float*)(ws + WS_ROPEC); E.ropes = (const float*)(ws + WS_ROPES);
        pg8::Gemm g{(const bf16_t*)(ws + WS_H), (const bf16_t*)(ws + WS_WIN), M / 256, NIN / 256, D};
        S.init(g.nM, g.nN, gridDim.x, blockIdx.x);
        pg8::gemm_phase<EpiInProj>(lds, g, S, E, wv);
    }
    SEAM(2);
    if (IN(3)) {
#if MK_MULTI
        {
            EpiBf16 E; E.O = (bf16_t*)(ws + WS_KVC); E.ldc = 1536;
            pg8::Gemm g{(const bf16_t*)(ws + WS_H) + (size_t)M * D, (const bf16_t*)(ws + WS_WIN) + (size_t)512 * D, MC / 256, 1536 / 256, D};
            S.init(g.nM, g.nN, gridDim.x, (int)gridDim.x - 1 - (int)blockIdx.x);
            pg8::gemm_phase<EpiBf16>(lds, g, S, E, wv);
        }
        phase_kvinc(p, lds, wv, (int)blockIdx.x, 1024, (int)gridDim.x);
        phase_dft<0>(p, lds, wv, (int)blockIdx.x, 256, (int)gridDim.x);
#else
        {
            EpiBf16 E; E.O = (bf16_t*)(ws + WS_KVC); E.ldc = 1536;
            pg8::Gemm g{(const bf16_t*)(ws + WS_H) + (size_t)M * D, (const bf16_t*)(ws + WS_WIN) + (size_t)512 * D, MC / 256, 1536 / 256, D};
            S.init(g.nM, g.nN, gridDim.x, (int)gridDim.x - 1 - (int)blockIdx.x);
            pg8::gemm_phase<EpiBf16>(lds, g, S, E, wv);
        }
        unsigned* qctr = (unsigned*)(ws + WS_XBAR) + 3600;
        volatile LAS unsigned* qslot = (volatile LAS unsigned*)(lds + 131072 + 640);
        for (;;) {
            __syncthreads();
            if (t0) qslot[0] = __hip_atomic_fetch_add(qctr, 1u, __ATOMIC_RELAXED, __HIP_MEMORY_SCOPE_AGENT);
            __syncthreads();
            const int id = __builtin_amdgcn_readfirstlane((int)qslot[0]);
            if (id >= 256 + 1024) break;
            if (id < 256) phase_dft<0>(p, lds, wv, id, id + 1, 1);
            else phase_kvinc(p, lds, wv, id - 256, id - 255, 1);
        }
#endif
    }
    SEAM(3);
    if (IN(4)) { phase_scan(p, wv); phase_dft<1>(p, lds, wv, (int)blockIdx.x, 256, (int)gridDim.x); }
    SEAM(4);
    if (IN(5)) phase_retout(p, lds, wv);
    SEAM(5);
    if (IN(6)) {
        {
            EpiBf16 E; E.O = (bf16_t*)(ws + WS_RETD); E.ldc = D;
            pg8::Gemm g{(const bf16_t*)((unsigned char*)p.out + DO_R), (const bf16_t*)(ws + WS_WRO), M / 256, D / 256, D};
            S.init(g.nM, g.nN, gridDim.x, blockIdx.x);
            pg8::gemm_phase<EpiBf16>(lds, g, S, E, wv);
        }
        {
            EpiBf16 E; E.O = (bf16_t*)(ws + WS_FOURD); E.ldc = D;
            pg8::Gemm g{(const bf16_t*)(ws + WS_Z), (const bf16_t*)(ws + WS_WFO), M / 256, D / 256, 512};
            S.init(g.nM, g.nN, gridDim.x, blockIdx.x);
            pg8::gemm_phase<EpiBf16>(lds, g, S, E, wv);
        }
    }
    SEAM(6);
    if (IN(7)) {
        EpiMerge E; E.retd = (const bf16_t*)(ws + WS_RETD); E.fourd = (const bf16_t*)(ws + WS_FOURD); E.bbg = p.b_bg; E.merged = (bf16_t*)(ws + WS_MERGED);
        pg8::Gemm g{(const bf16_t*)(ws + WS_H), (const bf16_t*)(ws + WS_WBG), M / 256, 2048 / 256, D};
        S.init(g.nM, g.nN, gridDim.x, blockIdx.x);
        pg8::gemm_phase<EpiMerge>(lds, g, S, E, wv);
    }
    SEAM(7);
    if (IN(8)) {
        EpiResidT<false, true> E; E.xin = (const void*)p.x; E.gate = modv + 2048; E.out = (void*)(ws + WS_X1);
        pg8::Gemm g{(const bf16_t*)(ws + WS_MERGED), (const bf16_t*)(ws + WS_WOUT), M / 256, D / 256, D};
        S.init(g.nM, g.nN, gridDim.x, blockIdx.x);
        pg8::gemm_phase<EpiResidT<false, true>>(lds, g, S, E, wv);
    }
    SEAM(8);
    if (IN(9)) {
        bf16_t* hb = (bf16_t*)(ws + WS_H); const bf16_t* x1 = (const bf16_t*)(ws + WS_X1);
        const int ln = lane_id();
        for (int r = gw; r < M; r += 2 * NGW) {
            const int r1 = r + NGW; const bool v1 = r1 < M; const int q1 = v1 ? r1 : r; const int b0 = r >> 13, b1 = q1 >> 13;
            u32x2 a[4], c[4]; f32x4 fa[4], fc[4]; float s0 = 0.f, s1 = 0.f;
#pragma unroll
            for (int j = 0; j < 4; ++j) { a[j] = ld_nt((const u32x2*)(x1 + (size_t)r * D + 4 * ln + 256 * j)); c[j] = ld_nt((const u32x2*)(x1 + (size_t)q1 * D + 4 * ln + 256 * j)); }
#pragma unroll
            for (int j = 0; j < 4; ++j) {
                fa[j] = (f32x4){bf_lo(a[j].x), bf_hi(a[j].x), bf_lo(a[j].y), bf_hi(a[j].y)}; fc[j] = (f32x4){bf_lo(c[j].x), bf_hi(c[j].x), bf_lo(c[j].y), bf_hi(c[j].y)};
                s0 += (fa[j][0] * fa[j][0] + fa[j][1] * fa[j][1]) + (fa[j][2] * fa[j][2] + fa[j][3] * fa[j][3]);
                s1 += (fc[j][0] * fc[j][0] + fc[j][1] * fc[j][1]) + (fc[j][2] * fc[j][2] + fc[j][3] * fc[j][3]);
            }
#pragma unroll
            for (int o = 1; o < 64; o <<= 1) { s0 += __shfl_xor(s0, o); s1 += __shfl_xor(s1, o); }
            const float rs0 = rsqrtf(s0 * (1.f / D) + EPS), rs1 = rsqrtf(s1 * (1.f / D) + EPS);
#pragma unroll
            for (int j = 0; j < 4; ++j) {
                const int cidx = 4 * ln + 256 * j; const f32x4 wv_ = *(const f32x4*)(p.norm2_w + cidx);
                const f32x4 y0 = fa[j] * rs0 * wv_ * (*(const f32x4*)(modv + b0 * 6144 + 4096 + cidx) + 1.f) + *(const f32x4*)(modv + b0 * 6144 + 3072 + cidx);
                const f32x4 y1 = fc[j] * rs1 * wv_ * (*(const f32x4*)(modv + b1 * 6144 + 4096 + cidx) + 1.f) + *(const f32x4*)(modv + b1 * 6144 + 3072 + cidx);
                u32x2 w0; w0.x = cvt_pk_bf16(y0[0], y0[1]); w0.y = cvt_pk_bf16(y0[2], y0[3]); *(u32x2*)(hb + (size_t)r * D + cidx) = w0;
                if (v1) { u32x2 w1; w1.x = cvt_pk_bf16(y1[0], y1[1]); w1.y = cvt_pk_bf16(y1[2], y1[3]); *(u32x2*)(hb + (size_t)q1 * D + cidx) = w1; }
            }
        }
    }
    SEAM(9);
    if (IN(10)) {
        EpiUpConv E; E.convw = p.conv_w; E.convb = p.conv_b; E.act = (bf16_t*)(ws + WS_ACT); E.wl = (LAS float*)(lds + 131072 + 1024);
        pg8::Gemm g{(const bf16_t*)(ws + WS_H), (const bf16_t*)(ws + WS_WUP), CONV_NM, NUP / 256, D};
        S.init(g.nM, g.nN, gridDim.x, blockIdx.x);
        pg8::gemm_phase<EpiUpConv, true>(lds, g, S, E, wv);
    }
    SEAM(10);
    if (IN(11)) {
        EpiResidT<true, true> E; E.xin = (const void*)(ws + WS_X1); E.gate = modv + 5120; E.out = (void*)(ws + WS_X2B);
        pg8::Gemm g{(const bf16_t*)(ws + WS_ACT), (const bf16_t*)(ws + WS_WDN), M / 256, D / 256, FFN};
        S.init(g.nM, g.nN, gridDim.x, blockIdx.x);
        pg8::gemm_phase<EpiResidT<true, true>>(lds, g, S, E, wv);
    }
    SEAM(11);
    if (IN(12)) {
        const int ln = lane_id(); const bf16_t* x2 = (const bf16_t*)(ws + WS_X2B);
        for (int r = gw; r < M; r += 2 * NGW) {
            const int r1 = r + NGW; const bool v1 = r1 < M; const int q1 = v1 ? r1 : r;
            u32x2 a[4], c[4]; f32x4 fa[4], fc[4]; float s0 = 0.f, s1 = 0.f;
#pragma unroll
            for (int j = 0; j < 4; ++j) { a[j] = ld_nt((const u32x2*)(x2 + (size_t)r * D + 4 * ln + 256 * j)); c[j] = ld_nt((const u32x2*)(x2 + (size_t)q1 * D + 4 * ln + 256 * j)); }
#pragma unroll
            for (int j = 0; j < 4; ++j) {
                fa[j] = (f32x4){bf_lo(a[j].x), bf_hi(a[j].x), bf_lo(a[j].y), bf_hi(a[j].y)}; fc[j] = (f32x4){bf_lo(c[j].x), bf_hi(c[j].x), bf_lo(c[j].y), bf_hi(c[j].y)};
                s0 += (fa[j][0] * fa[j][0] + fa[j][1] * fa[j][1]) + (fa[j][2] * fa[j][2] + fa[j][3] * fa[j][3]);
                s1 += (fc[j][0] * fc[j][0] + fc[j][1] * fc[j][1]) + (fc[j][2] * fc[j][2] + fc[j][3] * fc[j][3]);
            }
#pragma unroll
            for (int o = 1; o < 64; o <<= 1) { s0 += __shfl_xor(s0, o); s1 += __shfl_xor(s1, o); }
            const float rs0 = rsqrtf(s0 * (1.f / D) + EPS), rs1 = rsqrtf(s1 * (1.f / D) + EPS);
#pragma unroll
            for (int j = 0; j < 4; ++j) {
                const int cidx = 4 * ln + 256 * j; const f32x4 wv_ = *(const f32x4*)(p.fnorm_w + cidx);
                st_nt((f32x4*)(p.out + (size_t)r * D + cidx), fa[j] * rs0 * wv_);
                if (v1) st_nt((f32x4*)(p.out + (size_t)q1 * D + cidx), fc[j] * rs1 * wv_);
            }
        }
    }
}

constexpr int N_PHASES = 13;

extern "C" void kernel_launch(void* const* d_in, const int* in_sizes, int n_in, void* d_out, int out_size, void* d_ws, size_t ws_size, hipStream_t stream) {
    static int grid = 0;
    if (grid == 0) {
        int dev = 0, cus = 0, per_cu = 0;
        if (hipGetDevice(&dev) != hipSuccess || hipDeviceGetAttribute(&cus, hipDeviceAttributeMultiprocessorCount, dev) != hipSuccess) { fprintf(stderr, "kernel_launch: device query failed\n"); grid = -1; return; }
        if (hipFuncSetAttribute((const void*)mk_fwd, hipFuncAttributeMaxDynamicSharedMemorySize, LDS_BYTES) != hipSuccess) { fprintf(stderr, "kernel_launch: hipFuncSetAttribute failed\n"); grid = -1; return; }
        if (hipOccupancyMaxActiveBlocksPerMultiprocessor(&per_cu, (const void*)mk_fwd, 512, LDS_BYTES) != hipSuccess || per_cu < 1) { fprintf(stderr, "kernel_launch: occupancy query says %d\n", per_cu); per_cu = 1; }
        (void)hipGetLastError();
        grid = cus * 1;
        if (ws_size < 256 * MiB) { fprintf(stderr, "kernel_launch: workspace too small (%zu)\n", ws_size); grid = -1; return; }
    }
    if (grid < 0) return;
    Params p{};
    p.x = (const float*)d_in[0]; p.c = (const float*)d_in[1]; p.ctx = (const float*)d_in[2]; p.c_ctx = (const float*)d_in[3]; p.w_mod = (const float*)d_in[4]; p.b_mod = (const float*)d_in[5];
    p.norm1_w = (const float*)d_in[6]; p.w_in = (const float*)d_in[7]; p.dec_f = (const float*)d_in[8]; p.dec_b = (const float*)d_in[9]; p.w_ro = (const float*)d_in[10]; p.w_fo = (const float*)d_in[11];
    p.w_bg = (const float*)d_in[12]; p.b_bg = (const float*)d_in[13]; p.w_out = (const float*)d_in[14]; p.norm2_w = (const float*)d_in[15]; p.w_up = (const float*)d_in[16]; p.conv_w = (const float*)d_in[17];
    p.conv_b = (const float*)d_in[18]; p.w_down = (const float*)d_in[19]; p.fnorm_w = (const float*)d_in[20];
    p.out = (float*)d_out; p.ws = (unsigned char*)d_ws;
#if MK_MULTI
    for (int ph = 0; ph < N_PHASES; ++ph) {
        p.ph_lo = ph; p.ph_hi = ph + 1;
        hipLaunchKernelGGL(mk_fwd, dim3(grid), dim3(512), LDS_BYTES, stream, p);
#ifdef DBG_CHECK
        int* fl = (int*)((unsigned char*)d_ws + 3 * MiB);
        if (ph == 0) { hipMemsetAsync(fl, 0x3f, 4, stream); hipMemsetAsync(fl + 1, 0, 4, stream); hipMemsetAsync(fl + 32, 0, 1024, stream); }
#define VER(id) hipLaunchKernelGGL(dbg_verify, dim3(64), dim3(128), 0, stream, p, id, fl)
        if (ph == 0) VER(1);
        if (ph == 1) VER(2);
        if (ph == 2) { VER(3); VER(4); VER(5); }
        if (ph == 3) { VER(6); VER(7); }
        if (ph == 4) { VER(8); VER(9); }
        if (ph == 5) VER(10);
        if (ph == 6) VER(11);
        if (ph == 7) VER(12);
        if (ph == 8) VER(13);
        if (ph == 9) VER(14);
        if (ph == 10) VER(15);
        if (ph == 11) { VER(16); VER(17); }
        if (ph == 12) hipLaunchKernelGGL(dbg_fin, dim3(16384), dim3(256), 0, stream, (float*)d_out, (const int*)fl);
#endif
    }
#else
#if defined(REP_LO)
    const int los[2] = {0, REP_LO}, his[2] = {REP_HI, N_PHASES};
    for (int li = 0; li < 2; ++li) {
        p.ph_lo = los[li]; p.ph_hi = his[li];
        (void)hipMemsetAsync((unsigned char*)d_ws + WS_XBAR, 0, 16384, stream);
        void* args[] = {&p};
        hipError_t e = hipLaunchCooperativeKernel((const void*)mk_fwd, dim3(grid), dim3(512), args, LDS_BYTES, stream);
        if (e != hipSuccess) fprintf(stderr, "kernel_launch: cooperative launch failed: %s (grid %d)\n", hipGetErrorString(e), grid);
    }
#else
    (void)hipMemsetAsync((unsigned char*)d_ws + WS_XBAR, 0, 16384, stream);
    p.ph_lo = 0; p.ph_hi = N_PHASES;
    void* args[] = {&p};
    hipError_t e = hipLaunchCooperativeKernel((const void*)mk_fwd, dim3(grid), dim3(512), args, LDS_BYTES, stream);
    if (e != hipSuccess) fprintf(stderr, "kernel_launch: cooperative launch failed: %s (grid %d)\n", hipGetErrorString(e), grid);
#endif
#endif
}
```
